# Optimizing an MI355X kernel written in HIP

```python
import math, functools
import jax, jax.numpy as jnp
from jax import lax
import numpy as np

D_MODEL = 1024
BATCH = 4
SEQ = 4096
DEPTH = 2

CTX_LEN = 256
GRID_W = 64
D_FF = 4 * D_MODEL
NORM_EPS = 1e-6
S5_W = D_MODEL // 4
S5_GROUP = 16
S5_G = S5_W // S5_GROUP
S5_P = 64
S5_DT_MIN = 1e-3
S5_DT_MAX = 1e-1
HG_W = 3 * D_MODEL // 8
HG_DK = 64
HG_H = HG_W // HG_DK
HG_CHUNK = 64
HG_COLS = 5 * HG_W
RW_W = 3 * D_MODEL // 8
RW_N = 64
RW_H = RW_W // RW_N
RW_W_LORA = 64
RW_A_LORA = 64
RW_G_LORA = 128
RW_GN_EPS = 64e-5
RW_COLS = 3 * RW_W + 2 * RW_W_LORA + 2 * RW_A_LORA + RW_G_LORA
IN_COLS = S5_W + HG_COLS + RW_COLS

kernel_name = 'hybrid_s5_hgrn2_rwkv7_flow_block'


def _f32(t):
    return t.astype(jnp.float32)


def _rmsnorm(x, g):
    xf = _f32(x)
    y = xf * lax.rsqrt(jnp.mean(xf * xf, axis=-1, keepdims=True) + NORM_EPS)
    return (y * _f32(g)).astype(x.dtype)


def _modulate(h, shift, scale):
    return h * (1 + scale) + shift


def _split(z, widths):
    return jnp.split(z, [int(i) for i in np.cumsum(widths)[:-1]], axis=-1)


def _heads(t, dh):
    return t.reshape(t.shape[:-1] + (t.shape[-1] // dh, dh))


def _merge(t):
    return t.reshape(t.shape[:-2] + (t.shape[-2] * t.shape[-1],))


def _to_colmajor(z, rows):
    b, n, ch = z.shape
    return z.reshape(b, rows, GRID_W, ch).transpose(0, 2, 1, 3).reshape(b, n, ch)


def _to_rowmajor(z, rows):
    b, n, ch = z.shape
    return z.reshape(b, GRID_W, rows, ch).transpose(0, 2, 1, 3).reshape(b, n, ch)


def _mlp(h, w1, w2):
    return jnp.square(jax.nn.relu(h @ w1)) @ w2


def _flip(t):
    return tuple(jnp.flip(a, axis=1) for a in t)


def _bidirectional(scan_f, scan_b, ctx_f, lat_f, ctx_b, lat_b, s0, ctx_out):
    yc_f, sc_f = scan_f(ctx_f, s0)
    yl_f, _ = scan_f(lat_f, sc_f)
    yc_b, sc_b = scan_b(_flip(ctx_b), s0)
    yl_b, _ = scan_b(_flip(lat_b), sc_b)
    y_lat = yl_f + jnp.flip(yl_b, axis=1)
    y_ctx = yc_f + jnp.flip(yc_b, axis=1) if ctx_out else None
    return y_ctx, y_lat


def _s5_scan(ar, ai, cr, ci, inputs, s0):
    br, bi = inputs
    s0r, s0i = s0
    br = br.at[:, 0].add(ar * s0r - ai * s0i)
    bi = bi.at[:, 0].add(ar * s0i + ai * s0r)
    a_r = jnp.broadcast_to(ar, br.shape)
    a_i = jnp.broadcast_to(ai, bi.shape)

    def combine(e1, e2):
        a1r, a1i, b1r, b1i = e1
        a2r, a2i, b2r, b2i = e2
        return (a2r * a1r - a2i * a1i, a2r * a1i + a2i * a1r,
                a2r * b1r - a2i * b1i + b2r, a2r * b1i + a2i * b1r + b2i)

    _, _, hr, hi = lax.associative_scan(combine, (a_r, a_i, br, bi), axis=1)
    y = jnp.einsum('blgp,ghp->blgh', hr, cr) - jnp.einsum('blgp,ghp->blgh', hi, ci)
    return y.reshape(y.shape[0], y.shape[1], S5_W), (hr[:, -1], hi[:, -1])


def _s5_mixer(uc, ul, lam_re, lam_im, log_step, b_re, b_im, c_re, c_im, d, w_glu, b_glu, ctx_out):
    lam_re, lam_im, log_step = _f32(lam_re), _f32(lam_im), _f32(log_step)
    b_re, b_im, c_re, c_im = _f32(b_re), _f32(b_im), _f32(c_re), _f32(c_im)
    step = jnp.exp(log_step)[..., None]
    mag = jnp.exp(lam_re * step)
    ar = mag * jnp.cos(lam_im * step)
    ai = mag * jnp.sin(lam_im * step)
    den = lam_re * lam_re + lam_im * lam_im
    fr = ((ar - 1.0) * lam_re + ai * lam_im) / den
    fi = (ai * lam_re - (ar - 1.0) * lam_im) / den
    bbr = fr[..., None] * b_re - fi[..., None] * b_im
    bbi = fr[..., None] * b_im + fi[..., None] * b_re

    def drive(u, dr):
        ug = u.reshape(u.shape[0], u.shape[1], S5_G, S5_GROUP)
        return (jnp.einsum('blgh,gph->blgp', ug, bbr[dr]), jnp.einsum('blgh,gph->blgp', ug, bbi[dr]))

    scan_f = functools.partial(_s5_scan, ar[0], ai[0], c_re[0], c_im[0])
    scan_b = functools.partial(_s5_scan, ar[1], ai[1], c_re[1], c_im[1])
    zero = jnp.zeros((uc.shape[0], S5_G, S5_P), jnp.float32)
    yc, yl = _bidirectional(scan_f, scan_b, drive(uc, 0), drive(ul, 0), drive(uc, 1), drive(ul, 1),
                            (zero, zero), ctx_out)

    def readout(y, u):
        y = jax.nn.gelu(y + d * u)
        return y * jax.nn.sigmoid(y @ w_glu + b_glu)

    return (readout(yc, uc) if ctx_out else None), readout(yl, ul)


def _hgrn2_scan(inputs, s0):
    q, k, v, log_f = inputs
    b_, n_tok, nh, _ = q.shape
    n_chunks = n_tok // HG_CHUNK

    def chunks(t):
        return t.reshape(b_, n_chunks, HG_CHUNK, nh, t.shape[-1]).transpose(1, 0, 3, 2, 4)

    lower = jnp.tril(jnp.ones((HG_CHUNK, HG_CHUNK), bool))[:, :, None]

    def step(S, inp):
        qc, kc, vc, gc = inp
        cum = jnp.cumsum(gc, axis=2)
        rel = jnp.exp(jnp.where(lower, cum[:, :, :, None] - cum[:, :, None], -jnp.inf))
        scores = jnp.einsum('bhti,bhtsi,bhsi->bhts', qc, rel, kc)
        o = scores @ vc + jnp.einsum('bhti,bhij->bhtj', qc * jnp.exp(cum), S)
        last = cum[:, :, -1:]
        S = jnp.exp(last[:, :, 0])[..., None] * S + jnp.einsum('bhsi,bhsj->bhij', kc * jnp.exp(last - cum), vc)
        return S, o

    S, o = lax.scan(step, s0, tuple(chunks(t) for t in inputs))
    return o.transpose(1, 0, 3, 2, 4).reshape(b_, n_tok, nh, v.shape[-1]), S


def _hgrn2_mixer(zc, zl, lb, norm_g, ctx_out):
    log_lb = jnp.log(lb)
    log_1m_lb = jnp.log1p(-lb)

    def prep(z, dr):
        q, i, f_f, f_b, _ = _split(z, [HG_W] * 5)
        fz = (f_f, f_b)[dr]
        k = (1.0 - lb[dr]) * jax.nn.sigmoid(-fz)
        log_f = jnp.logaddexp(log_lb[dr], log_1m_lb[dr] + jax.nn.log_sigmoid(fz))
        return (_heads(jax.nn.silu(q), HG_DK), _heads(k, HG_DK), _heads(i, HG_DK), _heads(log_f, HG_DK))

    s0 = jnp.zeros((zc.shape[0], HG_H, HG_DK, HG_DK), jnp.float32)
    oc, ol = _bidirectional(_hgrn2_scan, _hgrn2_scan, prep(zc, 0), prep(zl, 0), prep(zc, 1), prep(zl, 1),
                            s0, ctx_out)

    def readout(o, z):
        o = o * lax.rsqrt(jnp.mean(o * o, axis=-1, keepdims=True) + NORM_EPS)
        return _merge(o) * norm_g * jax.nn.silu(z[..., 4 * HG_W:])

    return (readout(oc, zc) if ctx_out else None), readout(ol, zl)


def _rwkv7_scan(inputs, s0):
    tm = tuple(jnp.moveaxis(t, 1, 0) for t in inputs)

    def step(S, inp):
        r, w, k, v, kk, a = inp
        sa = jnp.einsum('bhvk,bhk->bhv', S, -kk)
        S = S * w[:, :, None, :] + sa[..., None] * (kk * a)[:, :, None, :] + v[..., None] * k[:, :, None, :]
        return S, jnp.einsum('bhvk,bhk->bhv', S, r)

    S, y = lax.scan(step, s0, tm)
    return jnp.moveaxis(y, 0, 1), S


def _rwkv7_mixer(zc, zl, rows, mu, w0, w2, a0, a2, g2, k_k, k_a, r_k, ln_w, ln_b, ctx_out):
    widths = [RW_W] * 3 + [RW_W_LORA] * 2 + [RW_A_LORA] * 2 + [RW_G_LORA]

    def shift(z):
        zp = jnp.pad(z, ((0, 0), (1, 1), (0, 0)))
        return z + mu[0] * (zp[:, :-2] - z) + mu[1] * (zp[:, 2:] - z)

    def prep(z):
        r, k, v, wl_f, wl_b, al_f, al_b, gl = _split(shift(z), widths)
        rh, vh = _heads(r, RW_N), _heads(v, RW_N)
        kk = _heads(k * k_k, RW_N)
        kk = kk * lax.rsqrt(jnp.maximum(jnp.sum(kk * kk, axis=-1, keepdims=True), 1e-24))
        dirs = []
        for dr, (wl, al) in enumerate(((wl_f, al_f), (wl_b, al_b))):
            log_w = -jax.nn.softplus(-(w0[dr] + jnp.tanh(wl) @ w2[dr])) - 0.5
            a = jax.nn.sigmoid(a0[dr] + al @ a2[dr])
            kt = _heads(k * (1.0 + (a - 1.0) * k_a), RW_N)
            dirs.append((rh, _heads(jnp.exp(-jnp.exp(log_w)), RW_N), kt, vh, kk, _heads(a, RW_N)))
        return dirs, gl

    def readout(y, dirs, gl):
        m = jnp.mean(y, axis=-1, keepdims=True)
        var = jnp.mean(jnp.square(y - m), axis=-1, keepdims=True)
        y = _merge((y - m) * lax.rsqrt(var + RW_GN_EPS)) * ln_w + ln_b
        d0, d1 = dirs
        bonus = (jnp.sum(d0[0] * d0[2] * r_k, axis=-1, keepdims=True) * d0[3]
                 + jnp.sum(d1[0] * d1[2] * r_k, axis=-1, keepdims=True) * d1[3])
        return (y + _merge(bonus)) * (jax.nn.sigmoid(gl) @ g2)

    dc, gc = prep(zc)
    dl, gl_lat = prep(_to_colmajor(zl, rows))
    s0 = jnp.zeros((zc.shape[0], RW_H, RW_N, RW_N), jnp.float32)
    yc, yl = _bidirectional(_rwkv7_scan, _rwkv7_scan, dc[0], dl[0], dc[1], dl[1], s0, ctx_out)
    ol = _to_rowmajor(readout(yl, dl, gl_lat), rows)
    return (readout(yc, dc, gc) if ctx_out else None), ol


def _hgrn_lower_bounds(lb_param):
    p = jax.nn.softmax(_f32(lb_param), axis=0)
    cs = jnp.cumsum(p, axis=0)
    return cs - cs[:1]


def setup_inputs(seed: int = 0) -> dict:
    key = jax.random.key(seed)
    ks = iter(jax.random.split(key, 48))

    def nrm(shape, scale):
        return jax.random.normal(next(ks), shape, jnp.float32) * scale

    def unif(shape, lo, hi):
        return jax.random.uniform(next(ks), shape, jnp.float32, lo, hi)

    L = DEPTH
    D = D_MODEL
    n_idx = jnp.arange(S5_P, dtype=jnp.float32)
    return {
        'x': nrm((BATCH, SEQ, D), 1.0),
        'c': nrm((BATCH, D), 1.0),
        'ctx': nrm((BATCH, CTX_LEN, D), 1.0),
        'c_ctx': nrm((D,), 1.0),
        'w_mod': nrm((L, D, 6 * D), 0.5 * D ** -0.5),
        'b_mod': nrm((L, 6 * D), 0.02),
        'norm1_g': 1.0 + nrm((L, D), 0.02),
        'w_in': nrm((L, D, IN_COLS), D ** -0.5),
        's5_lam_re': -0.5 + nrm((L, 2, S5_G, S5_P), 0.01),
        's5_lam_im': math.pi * n_idx + nrm((L, 2, S5_G, S5_P), 0.01),
        's5_log_step': unif((L, 2, S5_G), math.log(S5_DT_MIN), math.log(S5_DT_MAX)),
        's5_b_re': nrm((L, 2, S5_G, S5_P, S5_GROUP), (2 * S5_GROUP) ** -0.5),
        's5_b_im': nrm((L, 2, S5_G, S5_P, S5_GROUP), (2 * S5_GROUP) ** -0.5),
        's5_c_re': nrm((L, 2, S5_G, S5_GROUP, S5_P), S5_P ** -0.5),
        's5_c_im': nrm((L, 2, S5_G, S5_GROUP, S5_P), S5_P ** -0.5),
        's5_d': nrm((L, S5_W), 0.5),
        's5_w_glu': nrm((L, S5_W, S5_W), S5_W ** -0.5),
        's5_b_glu': nrm((L, S5_W), 0.02),
        'hgrn_lb': nrm((L, 2, HG_W), 0.1),
        'hgrn_norm_g': 1.0 + nrm((L, HG_W), 0.02),
        'rwkv_mu': unif((L, 2, RW_COLS), 0.0, 0.5),
        'rwkv_w0': unif((L, 2, RW_W), -6.0, -1.0),
        'rwkv_w2': nrm((L, 2, RW_W_LORA, RW_W), 0.5 * RW_W_LORA ** -0.5),
        'rwkv_a0': nrm((L, 2, RW_W), 0.1),
        'rwkv_a2': nrm((L, 2, RW_A_LORA, RW_W), 0.5 * RW_A_LORA ** -0.5),
        'rwkv_g2': nrm((L, RW_G_LORA, RW_W), RW_G_LORA ** -0.5),
        'rwkv_k_k': 0.85 + nrm((L, RW_W), 0.02),
        'rwkv_k_a': 1.0 + nrm((L, RW_W), 0.02),
        'rwkv_r_k': nrm((L, RW_H, RW_N), 0.1),
        'rwkv_ln_w': 1.0 + nrm((L, RW_W), 0.02),
        'rwkv_ln_b': nrm((L, RW_W), 0.02),
        'w_out': nrm((L, D, D), D ** -0.5),
        'norm2_g': 1.0 + nrm((L, D), 0.02),
        'w_ff1': nrm((L, D, D_FF), D ** -0.5),
        'w_ff2': nrm((L, D_FF, D), D_FF ** -0.5),
        'norm_f_g': 1.0 + nrm((D,), 0.02),
    }


def reference(x, c, ctx, c_ctx, w_mod, b_mod, norm1_g, w_in, s5_lam_re, s5_lam_im, s5_log_step,
              s5_b_re, s5_b_im, s5_c_re, s5_c_im, s5_d, s5_w_glu, s5_b_glu, hgrn_lb, hgrn_norm_g,
              rwkv_mu, rwkv_w0, rwkv_w2, rwkv_a0, rwkv_a2, rwkv_g2, rwkv_k_k, rwkv_k_a, rwkv_r_k,
              rwkv_ln_w, rwkv_ln_b, w_out, norm2_g, w_ff1, w_ff2, norm_f_g):
    rows = x.shape[1] // GRID_W
    lower_bounds = _hgrn_lower_bounds(hgrn_lb)
    xl, xc = x, ctx
    for l in range(DEPTH):
        ctx_out = l < DEPTH - 1
        mod_l = [m[:, None, :] for m in _split(jax.nn.silu(c) @ w_mod[l] + b_mod[l], [D_MODEL] * 6)]
        mod_c = _split(jax.nn.silu(c_ctx) @ w_mod[l] + b_mod[l], [D_MODEL] * 6)

        hl = _modulate(_rmsnorm(xl, norm1_g[l]), mod_l[0], mod_l[1])
        hc = _modulate(_rmsnorm(xc, norm1_g[l]), mod_c[0], mod_c[1])
        zl_s5, zl_hg, zl_rw = _split(_f32(hl @ w_in[l]), [S5_W, HG_COLS, RW_COLS])
        zc_s5, zc_hg, zc_rw = _split(_f32(hc @ w_in[l]), [S5_W, HG_COLS, RW_COLS])

        s5c, s5l = _s5_mixer(zc_s5, zl_s5, s5_lam_re[l], s5_lam_im[l], s5_log_step[l], s5_b_re[l],
                             s5_b_im[l], s5_c_re[l], s5_c_im[l], s5_d[l], s5_w_glu[l], s5_b_glu[l], ctx_out)
        hgc, hgl = _hgrn2_mixer(zc_hg, zl_hg, lower_bounds[l], hgrn_norm_g[l], ctx_out)
        rwc, rwl = _rwkv7_mixer(zc_rw, zl_rw, rows, rwkv_mu[l], rwkv_w0[l], rwkv_w2[l], rwkv_a0[l],
                                rwkv_a2[l], rwkv_g2[l], rwkv_k_k[l], rwkv_k_a[l], rwkv_r_k[l],
                                rwkv_ln_w[l], rwkv_ln_b[l], ctx_out)

        yl = jnp.concatenate([s5l, hgl, rwl], axis=-1).astype(xl.dtype) @ w_out[l]
        xl = xl + mod_l[2] * yl
        xl = xl + mod_l[5] * _mlp(_modulate(_rmsnorm(xl, norm2_g[l]), mod_l[3], mod_l[4]), w_ff1[l], w_ff2[l])
        if ctx_out:
            yc = jnp.concatenate([s5c, hgc, rwc], axis=-1).astype(xc.dtype) @ w_out[l]
            xc = xc + mod_c[2] * yc
            xc = xc + mod_c[5] * _mlp(_modulate(_rmsnorm(xc, norm2_g[l]), mod_c[3], mod_c[4]), w_ff1[l], w_ff2[l])
    return _rmsnorm(xl, norm_f_g)
```

```cpp
#include <hip/hip_runtime.h>
#include <hip/hip_cooperative_groups.h>
#include <stdio.h>
namespace cg = cooperative_groups;

#define DI __device__ __forceinline__
typedef unsigned short bf16_t;
typedef float f32x4 __attribute__((ext_vector_type(4)));
typedef float f32x2 __attribute__((ext_vector_type(2)));
typedef short bf16x8 __attribute__((ext_vector_type(8)));

constexpr int NTOK = 17408, NLAT = 16384;
constexpr int LDS_BYTES = 131072;
#ifndef PHM
#define PHM 0xFFFF
#endif
#ifndef REPM
#define REPM 0
#endif
#define REP(bit) for (int _r = 0; _r < ((REPM & (bit)) ? 2 : 1); ++_r)

constexpr size_t OFF_XC = 0;
constexpr size_t OFF_MOD = 4194304;
constexpr size_t OFF_CB = OFF_MOD + 245760;
constexpr size_t OFF_S5ST = OFF_CB + 417792;
constexpr size_t OFF_HGF = OFF_S5ST + 4456448;
constexpr size_t OFF_R1 = OFF_HGF + 417792;
constexpr size_t OFF_R2 = OFF_R1 + 35651584;
constexpr size_t OFF_R3 = OFF_R2 + 53477376;
constexpr size_t OFF_R4 = OFF_R3 + 26738688;
constexpr size_t ARR = 13369344;
constexpr size_t OFF_V = OFF_R4;
constexpr size_t OFF_ZS5 = OFF_V + ARR;
constexpr size_t OFF_AUXA = OFF_ZS5 + 8912896;
constexpr size_t OFF_G5 = OFF_AUXA + 4456448;
constexpr size_t OFF_RWP = OFF_G5 + 8912896;
constexpr size_t OFF_ZHG = OFF_RWP;
constexpr size_t OFF_HGST = OFF_ZHG + 66846720;
constexpr size_t OFF_GATE = OFF_R3 + 9961472;
constexpr size_t OFF_WAUX = OFF_GATE + ARR;
constexpr size_t OFF_S5W = OFF_WAUX + 2048 * 384 * 2;
constexpr size_t OFF_WGLU = OFF_R3 + (size_t)3712 * 1024 * 2;
constexpr size_t OFF_HID = OFF_R4;
constexpr size_t WS_NEEDED = OFF_R4 + 142606336;
constexpr size_t OFF_BAR = WS_NEEDED;
static_assert(OFF_BAR + 3456 * 4 <= 268435456, "workspace");
static_assert(OFF_HGST + 26738688 <= WS_NEEDED, "ws2");
static_assert(OFF_RWP + 8 * ARR <= WS_NEEDED, "ws3");
static_assert(OFF_S5W + 393216 <= OFF_R4, "ws4");

struct P {
    const float *x, *c, *ctx, *c_ctx, *w_mod, *b_mod, *norm1_g, *w_in, *s5_lam_re, *s5_lam_im, *s5_log_step,
        *s5_b_re, *s5_b_im, *s5_c_re, *s5_c_im, *s5_d, *s5_w_glu, *s5_b_glu, *hgrn_lb, *hgrn_norm_g,
        *rwkv_mu, *rwkv_w0, *rwkv_w2, *rwkv_a0, *rwkv_a2, *rwkv_g2, *rwkv_k_k, *rwkv_k_a, *rwkv_r_k,
        *rwkv_ln_w, *rwkv_ln_b, *w_out, *norm2_g, *w_ff1, *w_ff2, *norm_f_g;
    float* out;
    unsigned char* ws;
};

DI int tidx() { int t = threadIdx.x; asm volatile("" : "+v"(t)); return t; }
DI int bidx() { int b = blockIdx.x; asm volatile("" : "+s"(b)); return b; }
DI float bf2f(bf16_t v) { return __uint_as_float(((unsigned)v) << 16); }
typedef __bf16 hwbf16x2 __attribute__((ext_vector_type(2)));
DI unsigned pack2(float lo, float hi) { const hwbf16x2 v = __builtin_convertvector((f32x2){lo, hi}, hwbf16x2); return __builtin_bit_cast(unsigned, v); }
DI bf16_t f2bf(float f) { return (bf16_t)(pack2(f, 0.f) & 0xffffu); }
DI float bflo(unsigned w) { return __uint_as_float(w << 16); }
DI float bfhi(unsigned w) { return __uint_as_float(w & 0xffff0000u); }
DI float frcp(float x) { return __builtin_amdgcn_rcpf(x); }
DI float sigm(float x) { return frcp(1.0f + __expf(-x)); }
DI float tanh_fast(float x) { return 1.0f - 2.0f * frcp(__expf(2.0f * x) + 1.0f); }

template <int CTRL> DI float dppf(float x) { return __builtin_bit_cast(float, __builtin_amdgcn_mov_dpp(__builtin_bit_cast(int, x), CTRL, 0xf, 0xf, true)); }
DI float red16(float x) { x += dppf<0xB1>(x); x += dppf<0x4E>(x); x += dppf<0x141>(x); x += dppf<0x128>(x); return x; }
DI float wave_sum(float v) {
    v = red16(v);
    const int b = __builtin_bit_cast(int, v);
    const float r0 = __builtin_bit_cast(float, __builtin_amdgcn_readlane(b, 0)), r1 = __builtin_bit_cast(float, __builtin_amdgcn_readlane(b, 16)),
                r2 = __builtin_bit_cast(float, __builtin_amdgcn_readlane(b, 32)), r3 = __builtin_bit_cast(float, __builtin_amdgcn_readlane(b, 48));
    return (r0 + r1) + (r2 + r3);
}
DI int rw_row(int step, int dr, int b) {
    if (dr == 0) return step < 256 ? NLAT + b * 256 + step : b * 4096 + (step - 256);
    return step < 256 ? NLAT + b * 256 + 255 - step : b * 4096 + 4095 - (step - 256);
}
DI void lds_barrier() { asm volatile("s_waitcnt lgkmcnt(0)" ::: "memory"); __builtin_amdgcn_s_barrier(); asm volatile("" ::: "memory"); }
DI int permrow(int m) { return m < NLAT ? ((m & ~4095) | ((m & 63) << 6) | ((m >> 6) & 63)) : m; }

namespace pg8 {
#define PG8_LAS __attribute__((address_space(3)))
typedef unsigned u32x4 __attribute__((ext_vector_type(4)));
constexpr int BM = 256, BK = 64, HALF = 128, HTB = HALF * BK * 2, STAGE_BYTES = 8 * HTB, NXCD = 8, WGM = 8;
DI int lds_byte(int r, int c) { const int st = (r >> 4) * 2 + (c >> 5), rr = r & 15, cc = c & 31, ob = rr * 64 + cc * 2; return st * 1024 + (ob ^ (((ob >> 9) & 1) << 5)); }
DI void stage_rc(int b, int& R, int& C) { const int st = b / 1024, sb = b % 1024, swz = sb ^ (((sb >> 9) & 1) << 5); R = (st >> 1) * 16 + swz / 64; C = (st & 1) * 32 + (swz % 64) / 2; }
struct Unit { int pm, pn; };
struct Gemm { const bf16_t* A; const bf16_t* Bt; int M, N, K; int lda, ldb, tps; };
struct StaticOrder {
    int nM, nN, nwg, G, c;
    DI void init(int M, int N, int G_, int c_) { nM = M / BM; nN = N / BM; nwg = nM * nN; G = G_; c = c_; }
    DI bool next(int i, Unit& u) const {
        const long L = (long)i * G + c; if (L >= nwg) return false;
        int wgid = (int)L; { const int q = nwg / NXCD, r = nwg % NXCD, xcd = wgid % NXCD, off = wgid / NXCD; wgid = (xcd < r ? xcd * (q + 1) : r * (q + 1) + (xcd - r) * q) + off; }
        const int nig = WGM * nN, gid = wgid / nig, fm = gid * WGM, gsz = (nM - fm) < WGM ? (nM - fm) : WGM;
        u.pm = fm + ((wgid % nig) % gsz); u.pn = (wgid % nig) / gsz; return true;
    }
};
template <class Epi>
DI void gemm_phase(PG8_LAS unsigned char* lds, const Gemm g, const StaticOrder& S, const Epi& E) {
    const int tid = tidx(), wid = __builtin_amdgcn_readfirstlane(tid >> 6), lane = tid & 63, wr = wid >> 2, wc = wid & 3, fr = lane & 15, fq = lane >> 4;
    const int K = g.K, nt = K / BK;
    unsigned voffA[2], voffB[2];
#pragma unroll
    for (int i = 0; i < 2; ++i) { int R, C; stage_rc(tid * 16 + i * 8192, R, C); voffA[i] = (unsigned)(R * g.lda + C) * 2u; voffB[i] = (unsigned)(R * g.ldb + C) * 2u; }
    const size_t kstep = (size_t)(BK * 2);
    const size_t hstepA = (size_t)HALF * g.lda * 2, hstepB = (size_t)HALF * g.ldb * 2;
    const size_t tstepA = 2 * hstepA, tstepB = 2 * hstepB;
    const int tps = g.tps;
    const size_t sstep = (size_t)K * 2;
    const unsigned ldsw = (unsigned)wid * 1024u;
    const int aoff = lds_byte(wr * 64 + fr, fq * 8), boff = lds_byte(wc * 32 + fr, fq * 8);
#define PG8_SA(b, h) (((b) * 2 + (h)) * HTB)
#define PG8_SB(b, h) ((4 + (b) * 2 + (h)) * HTB)
#define PG8_STAGE(bufoff, gbase, voff) do { _Pragma("unroll") for (int _i = 0; _i < 2; ++_i) \
        __builtin_amdgcn_global_load_lds((const unsigned*)((const char*)(gbase) + (voff)[_i]), (PG8_LAS unsigned*)(lds + (bufoff) + ldsw + _i * 8192), 16, 0, 0); } while (0)
#define PG8_LDA(dst, b, h) do { _Pragma("unroll") for (int m = 0; m < 4; ++m) _Pragma("unroll") for (int k = 0; k < 2; ++k) dst[m][k] = *(const PG8_LAS bf16x8*)(lds + PG8_SA(b, h) + aoff + m * 2048 + k * 1024); } while (0)
#define PG8_LDB(dst, b, h) do { _Pragma("unroll") for (int n = 0; n < 2; ++n) _Pragma("unroll") for (int k = 0; k < 2; ++k) dst[n][k] = *(const PG8_LAS bf16x8*)(lds + PG8_SB(b, h) + boff + n * 2048 + k * 1024); } while (0)
#define PG8_MMA(ai, bj, At, Bt) do { __builtin_amdgcn_s_setprio(1); _Pragma("unroll") for (int m = 0; m < 4; ++m) _Pragma("unroll") for (int n = 0; n < 2; ++n) _Pragma("unroll") for (int k = 0; k < 2; ++k) \
        acc[ai][bj][m][n] = __builtin_amdgcn_mfma_f32_16x16x32_bf16(Bt[n][k], At[m][k], acc[ai][bj][m][n], 0, 0, 0); __builtin_amdgcn_s_setprio(0); } while (0)
#define PG8_WAIT_V(n) asm volatile("s_waitcnt vmcnt(" #n ")" ::: "memory")
#define PG8_WAIT_L(n) asm volatile("s_waitcnt lgkmcnt(" #n ")" ::: "memory")
#define PG8_BAR __builtin_amdgcn_s_barrier()
#define PG8_SCHED __builtin_amdgcn_sched_barrier(0)
    Unit cur, nxt; int ui = 0;
    if (!S.next(0, cur)) return;
    f32x4 acc[2][2][4][2];
#pragma unroll
    for (int a = 0; a < 2; ++a)
#pragma unroll
        for (int b = 0; b < 2; ++b)
#pragma unroll
            for (int m = 0; m < 4; ++m)
#pragma unroll
                for (int n = 0; n < 2; ++n) acc[a][b][m][n] = (f32x4){0.f, 0.f, 0.f, 0.f};
    bf16x8 At[4][2], B0[2][2], B1[2][2];
    const char* cA = (const char*)g.A + (size_t)(cur.pm % tps) * tstepA + (size_t)(cur.pm / tps) * sstep; const char* cB = (const char*)g.Bt + (size_t)cur.pn * tstepB + (size_t)(cur.pm / tps) * sstep;
    PG8_STAGE(PG8_SB(0, 0), cB, voffB); PG8_STAGE(PG8_SA(0, 0), cA, voffA); PG8_STAGE(PG8_SB(0, 1), cB + hstepB, voffB); PG8_STAGE(PG8_SA(0, 1), cA + hstepA, voffA);
    if (wr == 1) PG8_BAR;
    PG8_WAIT_V(4); PG8_BAR;
    PG8_STAGE(PG8_SB(1, 0), cB + kstep, voffB); PG8_STAGE(PG8_SA(1, 0), cA + kstep, voffA); PG8_STAGE(PG8_SB(1, 1), cB + hstepB + kstep, voffB);
    PG8_WAIT_V(6); PG8_BAR;
    for (;;) {
        const bool has_next = S.next(ui + 1, nxt);
        const char* nA = has_next ? (const char*)g.A + (size_t)(nxt.pm % tps) * tstepA + (size_t)(nxt.pm / tps) * sstep : cA; const char* nB = has_next ? (const char*)g.Bt + (size_t)nxt.pn * tstepB + (size_t)(nxt.pm / tps) * sstep : cB;
        for (int t = 0; t < nt; t += 2) {
            const bool last = (t == nt - 2);
            const char* a1 = cA + (size_t)(t + 1) * kstep;
            const char* a2 = last ? nA : cA + (size_t)(t + 2) * kstep; const char* b2 = last ? nB : cB + (size_t)(t + 2) * kstep;
            const char* a3 = a2 + kstep; const char* b3 = b2 + kstep;
            PG8_LDB(B0, 0, 0); PG8_SCHED; PG8_LDA(At, 0, 0); PG8_STAGE(PG8_SA(1, 1), a1 + hstepA, voffA);
            PG8_WAIT_L(8); PG8_BAR; PG8_WAIT_L(0); PG8_MMA(0, 0, At, B0); PG8_BAR; PG8_SCHED;
            PG8_LDB(B1, 0, 1); PG8_STAGE(PG8_SB(0, 0), b2, voffB);
            PG8_BAR; PG8_WAIT_L(0); PG8_MMA(0, 1, At, B1); PG8_BAR;
            PG8_LDA(At, 0, 1); PG8_STAGE(PG8_SA(0, 0), a2, voffA);
            PG8_BAR; PG8_WAIT_L(0); PG8_MMA(1, 0, At, B0); PG8_BAR; PG8_SCHED;
            PG8_STAGE(PG8_SB(0, 1), b2 + hstepB, voffB);
            PG8_WAIT_V(6); PG8_BAR; PG8_MMA(1, 1, At, B1); PG8_BAR;
            PG8_LDB(B0, 1, 0); PG8_SCHED; PG8_LDA(At, 1, 0); PG8_STAGE(PG8_SA(0, 1), a2 + hstepA, voffA);
            PG8_WAIT_L(8); PG8_BAR; PG8_WAIT_L(0); PG8_MMA(0, 0, At, B0); PG8_BAR; PG8_SCHED;
            PG8_LDB(B1, 1, 1); PG8_STAGE(PG8_SB(1, 0), b3, voffB);
            PG8_BAR; PG8_WAIT_L(0); PG8_MMA(0, 1, At, B1); PG8_BAR;
            PG8_LDA(At, 1, 1); PG8_STAGE(PG8_SA(1, 0), a3, voffA);
            PG8_BAR; PG8_WAIT_L(0); PG8_MMA(1, 0, At, B0); PG8_BAR; PG8_SCHED;
            PG8_STAGE(PG8_SB(1, 1), b3 + hstepB, voffB);
            PG8_WAIT_V(6); PG8_BAR; PG8_MMA(1, 1, At, B1); PG8_BAR;
        }
        E(acc, cur, wr, wc, fr, fq);
        if (!has_next) break;
#pragma unroll
        for (int a = 0; a < 2; ++a)
#pragma unroll
            for (int b = 0; b < 2; ++b)
#pragma unroll
                for (int m = 0; m < 4; ++m)
#pragma unroll
                    for (int n = 0; n < 2; ++n) acc[a][b][m][n] = (f32x4){0.f, 0.f, 0.f, 0.f};
        cur = nxt; cA = nA; cB = nB; ++ui;
    }
    PG8_WAIT_V(0);
    if (wr == 0) PG8_BAR;
    PG8_BAR;
#undef PG8_SA
#undef PG8_SB
#undef PG8_STAGE
#undef PG8_LDA
#undef PG8_LDB
#undef PG8_MMA
#undef PG8_WAIT_V
#undef PG8_WAIT_L
#undef PG8_BAR
#undef PG8_SCHED
}
}

template <int MODE> struct Epi {
    bf16_t* o0; bf16_t* o1; bf16_t* o2;
    const float* xin_lat; float* xout_lat; const float* xin_ctx; float* xout_ctx; const float* gate;
    DI void operator()(const f32x4 (&acc)[2][2][4][2], const pg8::Unit& u, int wr, int wc, int fr, int fq) const {
#pragma unroll
        for (int ai = 0; ai < 2; ++ai)
#pragma unroll
            for (int m = 0; m < 4; ++m) {
                const int row = u.pm * 256 + ai * 128 + wr * 64 + m * 16 + fr;
#pragma unroll
                for (int bj = 0; bj < 2; ++bj)
#pragma unroll
                    for (int n = 0; n < 2; ++n) {
                        const int col = u.pn * 256 + bj * 128 + wc * 32 + n * 16 + 4 * fq;
                        const f32x4 v = acc[ai][bj][m][n];
                        if (MODE == 0) {
                            uint2 w; w.x = pack2(v[0], v[1]); w.y = pack2(v[2], v[3]);
                            if (col < 1536) *(uint2*)(o0 + (size_t)permrow(row) * 1536 + col) = w;
                            else *(uint2*)(o1 + (size_t)row * 256 + (col - 1536)) = w;
                        } else if (MODE == 7) {
                            uint2 w; w.x = pack2(v[0], v[1]); w.y = pack2(v[2], v[3]);
                            if (col < 1536) *(uint2*)(o0 + (size_t)permrow(row) * 1536 + col) = w;
                            else if (col < 1792) *(uint2*)(o1 + (size_t)row * 256 + (col - 1536)) = w;
                            else if (col < 3712) *(uint2*)(o2 + (size_t)row * 1920 + (col - 1792)) = w;
                        } else if (MODE == 1) {
                            if (col < 1920) { uint2 w; w.x = pack2(v[0], v[1]); w.y = pack2(v[2], v[3]); *(uint2*)(o0 + (size_t)row * 1920 + col) = w; }
                        } else if (MODE == 2) {
                            const float* xi; float* xo; int s;
                            if (row < NLAT) { xi = xin_lat + (size_t)row * 1024 + col; xo = xout_lat + (size_t)row * 1024 + col; s = row >> 12; }
                            else { xi = xin_ctx + (size_t)(row - NLAT) * 1024 + col; xo = xout_ctx + (size_t)(row - NLAT) * 1024 + col; s = 4; }
                            const f32x4 xv = *(const f32x4*)xi; const f32x4 gv = *(const f32x4*)(gate + s * 6144 + col);
                            *(f32x4*)xo = xv + gv * v;
                        } else if (MODE == 4) {
                            uint2 w; w.x = pack2(v[0], v[1]); w.y = pack2(v[2], v[3]);
                            if (col < 1536) *(uint2*)(o0 + (size_t)row * 1536 + col) = w;
                            else if (col < 1920) *(uint2*)(o1 + (size_t)row * 384 + (col - 1536)) = w;
                        } else if (MODE == 5) {
                            const uint2 gw = *(const uint2*)(o1 + (size_t)row * 256 + col);
                            const f32x4 bv = *(const f32x4*)(gate + col);
                            const float g0 = bflo(gw.x), g1 = bfhi(gw.x), g2 = bflo(gw.y), g3 = bfhi(gw.y);
                            uint2 w; w.x = pack2(g0 * sigm(v[0] + bv[0]), g1 * sigm(v[1] + bv[1])); w.y = pack2(g2 * sigm(v[2] + bv[2]), g3 * sigm(v[3] + bv[3]));
                            *(uint2*)(o0 + (size_t)row * 1024 + col) = w;
                            __builtin_amdgcn_sched_barrier(0);
                        } else if (MODE == 6) {
                            *(f32x4*)(xout_lat + (size_t)row * 1024 + col) = v;
                        } else {
                            f32x4 r;
#pragma unroll
                            for (int j = 0; j < 4; ++j) { const float t = fmaxf(v[j], 0.f); r[j] = t * t; }
                            uint2 w; w.x = pack2(r[0], r[1]); w.y = pack2(r[2], r[3]);
                            *(uint2*)(o0 + (size_t)row * 4096 + col) = w;
                        }
                    }
            }
    }
};

DI void ph_mods(const P& p, float* lds) {
    float* sc = lds;
    float* red = lds + 5120;
    float* mod = (float*)(p.ws + OFF_MOD);
    const int tid = tidx(), lane = tid & 63, kg = tid >> 6;
    for (int it = bidx(); it < 192; it += gridDim.x) {
        const int l = it / 96, n0 = (it % 96) * 64;
        __syncthreads();
        for (int i = tid; i < 5120; i += 512) { const int s = i >> 10, k = i & 1023; const float v = s < 4 ? p.c[s * 1024 + k] : p.c_ctx[k]; sc[i] = v * frcp(1.f + __expf(-v)); }
        __syncthreads();
        float a0 = 0.f, a1 = 0.f, a2 = 0.f, a3 = 0.f, a4 = 0.f;
        const float* w = p.w_mod + (size_t)l * 1024 * 6144 + n0 + lane;
        for (int k = kg * 128; k < kg * 128 + 128; ++k) {
            const float wv = w[(size_t)k * 6144];
            a0 += sc[k] * wv; a1 += sc[1024 + k] * wv; a2 += sc[2048 + k] * wv; a3 += sc[3072 + k] * wv; a4 += sc[4096 + k] * wv;
        }
        red[(kg * 5 + 0) * 64 + lane] = a0; red[(kg * 5 + 1) * 64 + lane] = a1; red[(kg * 5 + 2) * 64 + lane] = a2; red[(kg * 5 + 3) * 64 + lane] = a3; red[(kg * 5 + 4) * 64 + lane] = a4;
        __syncthreads();
        if (tid < 320) { const int s = tid >> 6; float t = 0.f;
#pragma unroll
            for (int g = 0; g < 8; ++g) t += red[(g * 5 + s) * 64 + lane];
            mod[(l * 5 + s) * 6144 + n0 + lane] = t + p.b_mod[l * 6144 + n0 + lane]; }
    }
}


DI float swapadd32(float x) {
    const unsigned u = __float_as_uint(x);
    auto r = __builtin_amdgcn_permlane32_swap(u, u, false, false);
    return __uint_as_float(r[0]) + __uint_as_float(r[1]);
}
DI void ph_rwscan2(const P& p, float* lds) {
    float* buf = lds;
    float* ybuf = lds + 24576;
    float* ydummy = lds + 25600;
    const int tid = tidx();
    for (int it = bidx(); it < 192; it += gridDim.x) {
        const int rg = it & 3, dr = (it >> 2) & 1, h = (it >> 3) % 6, b = it / 48;
        __syncthreads();
        const int lane = tid & 63, wv = tid >> 6;
        const int half = lane >> 5, rsel = (lane >> 4) & 1, kc = lane & 15;
        const int rr = 2 * wv + rsel, k0 = (half * 16 + kc) * 2;
        const unsigned char* rwp = p.ws + OFF_RWP;
        bf16_t* YD = (bf16_t*)(p.ws + OFF_R2 + (size_t)dr * ARR);
        f32x2 S = (f32x2){0.f, 0.f};
        uint4 rawA[3], rawB[3];
        auto issue = [&](int j, uint4 (&raw)[3]) {
#pragma unroll
            for (int e = 0; e < 3; ++e) {
                const int q = tid + 512 * e; const int slot = q / 48, rem = q % 48; const int a = rem >> 3, part = rem & 7;
                const int row = rw_row(32 * j + slot, dr, b);
                const unsigned char* base = a == 0 ? rwp + (size_t)(2 + dr) * ARR : a == 1 ? rwp + ARR : a == 2 ? rwp + (size_t)(6 + dr) * ARR : a == 3 ? rwp + (size_t)(4 + dr) * ARR : a == 4 ? rwp : p.ws + OFF_V;
                raw[e] = *(const uint4*)(base + ((size_t)row * 384 + h * 64 + part * 8) * 2);
            }
        };
        auto commit = [&](int bsel, const uint4 (&raw)[3]) {
#pragma unroll
            for (int e = 0; e < 3; ++e) {
                const int q = tid + 512 * e; const int slot = q / 48, rem = q % 48; const int a = rem >> 3, part = rem & 7;
                f32x4 f0 = (f32x4){bflo(raw[e].x), bfhi(raw[e].x), bflo(raw[e].y), bfhi(raw[e].y)}, f1 = (f32x4){bflo(raw[e].z), bfhi(raw[e].z), bflo(raw[e].w), bfhi(raw[e].w)};
                if (a == 0) { f0 = 1.0f - f0; f1 = 1.0f - f1; }
                float* dst = buf + bsel * 12288 + (slot * 6 + a) * 64 + part * 8;
                *(f32x4*)dst = f0; *(f32x4*)(dst + 4) = f1;
            }
        };
        auto flush = [&](int j) {
            const int slot = tid >> 4, r16 = tid & 15;
            const int row = rw_row(32 * j + slot, dr, b);
            YD[(size_t)row * 384 + h * 64 + rg * 16 + r16] = f2bf(ybuf[(j & 1) * 512 + slot * 16 + r16]);
        };
        issue(0, rawA); commit(0, rawA); issue(1, rawA);
        asm volatile("s_waitcnt lgkmcnt(0)" ::: "memory"); __builtin_amdgcn_s_barrier(); asm volatile("" ::: "memory");
        for (int j = 0; j < 136; ++j) {
            if (j + 2 < 136) issue(j + 2, rawB);
            {
                const float* bb = buf + (j & 1) * 12288; float* yb = ybuf + (j & 1) * 512;
                const float* tb0 = bb + k0;
                f32x2 w2 = *(const f32x2*)(tb0), kk2 = *(const f32x2*)(tb0 + 64), kka2 = *(const f32x2*)(tb0 + 128), kt2 = *(const f32x2*)(tb0 + 192), r2 = *(const f32x2*)(tb0 + 256);
                float vv = bb[320 + rg * 16 + rr];
                float* yw = (kc == 0 && half == 0) ? (yb + rr) : (ydummy + tid);
                float yp = 0.f;
#pragma unroll 8
                for (int i = 0; i < 32; ++i) {
                    const int in = i < 31 ? i + 1 : 31;
                    const float* tn = bb + in * 384 + k0;
                    const f32x2 nw2 = *(const f32x2*)(tn), nkk2 = *(const f32x2*)(tn + 64), nkka2 = *(const f32x2*)(tn + 128), nkt2 = *(const f32x2*)(tn + 192), nr2 = *(const f32x2*)(tn + 256);
                    const float nvv = bb[in * 384 + 320 + rg * 16 + rr];
                    const f32x2 td = S * kk2;
                    float d = td[0] + td[1];
                    const f32x2 kv = kt2 * vv;
                    d += dppf<0xB1>(d); yp += dppf<0xB1>(yp);
                    d += dppf<0x4E>(d); yp += dppf<0x4E>(yp);
                    d += dppf<0x141>(d); yp += dppf<0x141>(yp);
                    d += dppf<0x128>(d); yp += dppf<0x128>(yp);
                    d = swapadd32(d); yp = swapadd32(yp);
                    if (i > 0) yw[(i - 1) * 16] = yp;
                    const float sa = -d;
                    S = S * w2 + (kka2 * sa + kv);
                    const f32x2 ty = S * r2;
                    yp = ty[0] + ty[1];
                    w2 = nw2; kk2 = nkk2; kka2 = nkka2; kt2 = nkt2; r2 = nr2; vv = nvv;
                }
                yp = red16(yp); yp = swapadd32(yp);
                yw[31 * 16] = yp;
            }
            if (j + 1 < 136) commit((j + 1) & 1, rawA);
            if (j > 0) flush(j - 1);
#pragma unroll
            for (int e = 0; e < 3; ++e) rawA[e] = rawB[e];
            asm volatile("s_waitcnt lgkmcnt(0)" ::: "memory"); __builtin_amdgcn_s_barrier(); asm volatile("" ::: "memory");
        }
        flush(135);
    }
}

DI void s5_abar(const P& p, int l, int dr, int g, int pp, float& ar, float& ai, float& fr, float& fi) {
    const float step = expf(p.s5_log_step[(l * 2 + dr) * 16 + g]);
    const float lr = p.s5_lam_re[((l * 2 + dr) * 16 + g) * 64 + pp], lim = p.s5_lam_im[((l * 2 + dr) * 16 + g) * 64 + pp];
    const float mag = expf(lr * step);
    ar = mag * cosf(lim * step); ai = mag * sinf(lim * step);
    const float den = lr * lr + lim * lim;
    fr = ((ar - 1.0f) * lr + ai * lim) / den;
    fi = (ai * lr - (ar - 1.0f) * lim) / den;
}

DI void ph_convert(const P& p, int l, float* lds, int part) {
    const int tid = tidx();
    bf16_t* wt = (bf16_t*)(p.ws + OFF_R3);
    const int ntask0 = part == 0 ? 64 * 3712 : 64 * 4096, ntask1 = part == 0 ? 64 * 1024 : 256 * 1024;
    for (int task = bidx() * 512 + tid; task < ntask0 + ntask1; task += gridDim.x * 512) {
        const float* W; int K, N, n, kb, drow; bf16_t* Wt;
        if (task < ntask0) {
            if (part == 0) { K = 1024; N = 3712; n = task % 3712; kb = task / 3712; W = p.w_in + (size_t)l * 1024 * 3712; Wt = wt;
                drow = n < 256 ? 1536 + n : (n < 2176 ? 1792 + (n - 256) : n - 2176); }
            else { K = 1024; N = 4096; n = task & 4095; kb = task >> 12; W = p.w_ff1 + (size_t)l * 1024 * 4096; Wt = wt + 3840 * 1024 + 1024 * 1024; drow = n; }
        } else {
            const int t2 = task - ntask0;
            if (part == 0) { K = 1024; N = 1024; n = t2 & 1023; kb = t2 >> 10; W = p.w_out + (size_t)l * 1024 * 1024; Wt = wt + 3840 * 1024; drow = n; }
            else { K = 4096; N = 1024; n = t2 & 1023; kb = t2 >> 10; W = p.w_ff2 + (size_t)l * 4096 * 1024; Wt = wt + 3840 * 1024 + 1024 * 1024 + 4096 * 1024; drow = n; }
        }
        const float* src = W + (size_t)(kb * 16) * N + n;
        float v[16];
#pragma unroll
        for (int j = 0; j < 16; ++j) v[j] = __builtin_nontemporal_load(src + (size_t)j * N);
        bf16_t* dst = Wt + (size_t)drow * K + kb * 16;
        *(uint4*)dst = make_uint4(pack2(v[0], v[1]), pack2(v[2], v[3]), pack2(v[4], v[5]), pack2(v[6], v[7]));
        *(uint4*)(dst + 8) = make_uint4(pack2(v[8], v[9]), pack2(v[10], v[11]), pack2(v[12], v[13]), pack2(v[14], v[15]));
    }
    if (part == 0) {
        bf16_t* waux = (bf16_t*)(p.ws + OFF_WAUX); bf16_t* wglu = (bf16_t*)(p.ws + OFF_WGLU);
        for (int i = bidx() * 512 + tid; i < 2048 * 384 + 65536 + 65536; i += gridDim.x * 512) {
            if (i < 2048 * 384) {
                const int n = i / 384, k = i % 384; float v = 0.f;
                if (n < 768) { const int dr = n / 384, c = n % 384; if ((k >> 6) == dr) v = p.rwkv_w2[((size_t)(l * 2 + dr) * 64 + (k & 63)) * 384 + c]; }
                else if (n < 1536) { const int dr = (n - 768) / 384, c = (n - 768) % 384; if ((k >> 6) == 2 + dr) v = p.rwkv_a2[((size_t)(l * 2 + dr) * 64 + (k & 63)) * 384 + c]; }
                else if (n < 1920) { if (k >= 256) v = p.rwkv_g2[((size_t)l * 128 + (k - 256)) * 384 + (n - 1536)]; }
                waux[i] = f2bf(v);
            } else if (i < 2048 * 384 + 65536) { const int j = i - 2048 * 384; const int n = j >> 8, k = j & 255; wglu[j] = f2bf(p.s5_w_glu[((size_t)l * 256 + k) * 256 + n]); }
            else { wglu[i - 2048 * 384] = 0; }
        }
        bf16_t* s5w = (bf16_t*)(p.ws + OFF_S5W);
        for (int i = bidx() * 512 + tid; i < 32 * 4096 + 32 * 2048; i += gridDim.x * 512) {
            if (i < 32 * 4096) {
                const int dg = i >> 12, pq = (i >> 5) & 127, hq = i & 31; const int dr = dg >> 4, g = dg & 15, pp = pq & 63;
                float v = 0.f;
                if (hq < 16) { float ar, ai, fr, fi; s5_abar(p, l, dr, g, pp, ar, ai, fr, fi);
                    const size_t bi = ((size_t)((l * 2 + dr) * 16 + g) * 64 + pp) * 16 + hq; const float br = p.s5_b_re[bi], bm = p.s5_b_im[bi];
                    v = pq < 64 ? fr * br - fi * bm : fr * bm + fi * br; }
                s5w[i] = f2bf(v);
            } else {
                const int j = i - 32 * 4096; const int dg = j >> 11, hh = (j >> 7) & 15, pq = j & 127; const int dr = dg >> 4, g = dg & 15;
                const size_t ci = (size_t)((l * 2 + dr) * 16 + g) * 1024 + hh * 64 + (pq & 63);
                s5w[i] = f2bf(pq < 64 ? p.s5_c_re[ci] : -p.s5_c_im[ci]);
            }
        }
    }
}

DI void ph_norm(const P& p, int l, int which, int nrows) {
    const float* g = (which ? p.norm2_g : p.norm1_g) + l * 1024;
    const int shc = which ? 3 : 0, scc = shc + 1;
    const int tid = tidx(), lane = tid & 63;
    const float* mod = (const float*)(p.ws + OFF_MOD);
    const float* xc = (const float*)(p.ws + OFF_XC);
    bf16_t* H = (bf16_t*)(p.ws + OFF_R1);
    const bool from_inputs = (l == 0 && which == 0);
    for (int m0 = (bidx() * 8 + (tid >> 6)) * 2; m0 < nrows; m0 += gridDim.x * 16) {
        f32x4 v[2][4]; float ss[2]; int sidx[2];
#pragma unroll
        for (int u = 0; u < 2; ++u) {
            const int m = m0 + u; const float* src;
            if (m < NLAT) { src = (from_inputs ? p.x : p.out) + (size_t)m * 1024; sidx[u] = m >> 12; }
            else { src = (from_inputs ? p.ctx : xc) + (size_t)(m - NLAT) * 1024; sidx[u] = 4; }
            ss[u] = 0.f;
            const bool addA = (l == 1 && which == 0 && m >= NLAT);
            const bool addB = (l == 0 && which == 1 && m >= NLAT);
            if (addB) src = p.ctx + (size_t)(m - NLAT) * 1024;
#pragma unroll
            for (int j = 0; j < 4; ++j) { v[u][j] = *(const f32x4*)(src + j * 256 + lane * 4);
                if (addA || addB) { const int col = j * 256 + lane * 4; f32x4 acc = (f32x4){0.f, 0.f, 0.f, 0.f};
                    const int nsl = addA ? 8 : 4;
                    for (int sl = 0; sl < nsl; ++sl) acc += *(const f32x4*)((const float*)(p.ws + OFF_R2) + ((size_t)sl * 1024 + (m - NLAT)) * 1024 + col);
                    v[u][j] += *(const f32x4*)(mod + (0 * 5 + 4) * 6144 + (addA ? 5 : 2) * 1024 + col) * acc;
                    if (addB) *(f32x4*)((float*)(p.ws + OFF_XC) + (size_t)(m - NLAT) * 1024 + col) = v[u][j]; } ss[u] += v[u][j][0] * v[u][j][0] + v[u][j][1] * v[u][j][1] + v[u][j][2] * v[u][j][2] + v[u][j][3] * v[u][j][3]; }
        }
#pragma unroll
        for (int u = 0; u < 2; ++u) {
            const int m = m0 + u;
            const float rstd = rsqrtf(wave_sum(ss[u]) * (1.0f / 1024.0f) + 1e-6f);
            const float* md = mod + (l * 5 + sidx[u]) * 6144;
#pragma unroll
            for (int j = 0; j < 4; ++j) {
                const int col = j * 256 + lane * 4;
                const f32x4 g4 = *(const f32x4*)(g + col), sh4 = *(const f32x4*)(md + shc * 1024 + col), sc4 = *(const f32x4*)(md + scc * 1024 + col);
                f32x4 h;
#pragma unroll
                for (int e = 0; e < 4; ++e) h[e] = v[u][j][e] * rstd * g4[e] * (1.0f + sc4[e]) + sh4[e];
                uint2 w; w.x = pack2(h[0], h[1]); w.y = pack2(h[2], h[3]);
                *(uint2*)(H + (size_t)m * 1024 + col) = w;
            }
        }
    }
}

DI void ph_rwp1(const P& p, int l, float* lds) {
    const int tid = tidx();
    const float* mu0 = p.rwkv_mu + (size_t)l * 2 * 1536; const float* mu1 = mu0 + 1536;
    const bf16_t* ZRW = (const bf16_t*)(p.ws + OFF_R2);
    bf16_t* Vv = (bf16_t*)(p.ws + OFF_V); bf16_t* AUXA = (bf16_t*)(p.ws + OFF_AUXA);
    bf16_t* Rr = (bf16_t*)(p.ws + OFF_RWP); bf16_t* KK = (bf16_t*)(p.ws + OFF_RWP + ARR); bf16_t* KTMP = (bf16_t*)(p.ws + OFF_RWP + 4 * ARR);
    const float* k_k = p.rwkv_k_k + l * 384;
    for (int task = bidx() * 512 + tid; task < NTOK * 192; task += gridDim.x * 512) {
        const int row = task / 192, cc = task % 192; const int col = cc * 8;
        int pos, slen;
        if (row < NLAT) { pos = row & 4095; slen = 4096; } else { pos = (row - NLAT) & 255; slen = 256; }
        const bf16_t* zr = ZRW + (size_t)row * 1536 + col;
        const uint4 z0 = make_uint4(0, 0, 0, 0);
        const uint4 zc = *(const uint4*)zr; const uint4 zp = pos > 0 ? *(const uint4*)(zr - 1536) : z0; const uint4 zn = (pos + 1 < slen) ? *(const uint4*)(zr + 1536) : z0;
        const unsigned cw[4] = {zc.x, zc.y, zc.z, zc.w}, pw[4] = {zp.x, zp.y, zp.z, zp.w}, nw[4] = {zn.x, zn.y, zn.z, zn.w};
        const f32x4 m0a = *(const f32x4*)(mu0 + col), m0b = *(const f32x4*)(mu0 + col + 4), m1a = *(const f32x4*)(mu1 + col), m1b = *(const f32x4*)(mu1 + col + 4);
        float o[8];
#pragma unroll
        for (int e = 0; e < 4; ++e) {
            const float c0 = bflo(cw[e]), c1 = bfhi(cw[e]), q0 = bflo(pw[e]), q1 = bfhi(pw[e]), n0 = bflo(nw[e]), n1 = bfhi(nw[e]);
            const float ma0 = e < 2 ? m0a[2 * e] : m0b[2 * e - 4], ma1 = e < 2 ? m0a[2 * e + 1] : m0b[2 * e - 3];
            const float mb0 = e < 2 ? m1a[2 * e] : m1b[2 * e - 4], mb1 = e < 2 ? m1a[2 * e + 1] : m1b[2 * e - 3];
            o[2 * e] = c0 + ma0 * (q0 - c0) + mb0 * (n0 - c0);
            o[2 * e + 1] = c1 + ma1 * (q1 - c1) + mb1 * (n1 - c1);
        }
        const int seg = cc / 48, c = (cc % 48) * 8;
        const size_t oo = (size_t)row * 384 + c;
        const f32x4 kka = *(const f32x4*)(k_k + c), kkb = *(const f32x4*)(k_k + c + 4);
        float kq[8]; float ss = 0.f;
#pragma unroll
        for (int e = 0; e < 8; ++e) { kq[e] = o[e] * (e < 4 ? kka[e] : kkb[e - 4]); ss += kq[e] * kq[e]; }
        ss += dppf<0xB1>(ss); ss += dppf<0x4E>(ss); ss += dppf<0x141>(ss);
        const float iv = rsqrtf(fmaxf(ss, 1e-24f));
        const uint4 po = make_uint4(pack2(o[0], o[1]), pack2(o[2], o[3]), pack2(o[4], o[5]), pack2(o[6], o[7]));
        if (seg == 0) *(uint4*)(Rr + oo) = po;
        else if (seg == 1) { *(uint4*)(KTMP + oo) = po;
            *(uint4*)(KK + oo) = make_uint4(pack2(kq[0] * iv, kq[1] * iv), pack2(kq[2] * iv, kq[3] * iv), pack2(kq[4] * iv, kq[5] * iv), pack2(kq[6] * iv, kq[7] * iv)); }
        else if (seg == 2) *(uint4*)(Vv + oo) = po;
        else {
            float a[8];
#pragma unroll
            for (int e = 0; e < 8; ++e) a[e] = c < 128 ? tanh_fast(o[e]) : (c >= 256 ? sigm(o[e]) : o[e]);
            *(uint4*)(AUXA + oo) = make_uint4(pack2(a[0], a[1]), pack2(a[2], a[3]), pack2(a[4], a[5]), pack2(a[6], a[7]));
        }
    }
}
DI void ph_rwp2(const P& p, int l) {
    const int tid = tidx(), lane = tid & 63, sub = lane >> 4, l16 = lane & 15;
    const bf16_t* PRE = (const bf16_t*)(p.ws + OFF_R2);
    const bf16_t* Rr = (const bf16_t*)(p.ws + OFF_RWP); const bf16_t* KK = (const bf16_t*)(p.ws + OFF_RWP + ARR);
    bf16_t* KT0 = (bf16_t*)(p.ws + OFF_RWP + 4 * ARR);
    float* CB = (float*)(p.ws + OFF_CB);
    for (int grp = bidx() * 8 + (tid >> 6); grp < NTOK * 6 / 4; grp += gridDim.x * 8) {
        const int task = grp * 4 + sub; const int row = task / 6, h = task % 6, c = h * 64 + l16 * 4;
        const size_t o = (size_t)row * 384 + c;
        const uint2 kx = *(const uint2*)(KT0 + o), kkx = *(const uint2*)(KK + o), rx = *(const uint2*)(Rr + o);
        uint2 pw[2], pa[2];
#pragma unroll
        for (int dr = 0; dr < 2; ++dr) { pw[dr] = *(const uint2*)(PRE + (size_t)row * 1536 + dr * 384 + c); pa[dr] = *(const uint2*)(PRE + (size_t)row * 1536 + 768 + dr * 384 + c); }
        const float k4[4] = {bflo(kx.x), bfhi(kx.x), bflo(kx.y), bfhi(kx.y)}, kk4[4] = {bflo(kkx.x), bfhi(kkx.x), bflo(kkx.y), bfhi(kkx.y)}, r4[4] = {bflo(rx.x), bfhi(rx.x), bflo(rx.y), bfhi(rx.y)};
        const f32x4 ka4 = *(const f32x4*)(p.rwkv_k_a + l * 384 + c), rk4 = *(const f32x4*)(p.rwkv_r_k + l * 384 + c);
        float bsum = 0.f;
#pragma unroll
        for (int dr = 0; dr < 2; ++dr) {
            const f32x4 w04 = *(const f32x4*)(p.rwkv_w0 + (l * 2 + dr) * 384 + c), a04 = *(const f32x4*)(p.rwkv_a0 + (l * 2 + dr) * 384 + c);
            const float pw4[4] = {bflo(pw[dr].x), bfhi(pw[dr].x), bflo(pw[dr].y), bfhi(pw[dr].y)}, pa4[4] = {bflo(pa[dr].x), bfhi(pa[dr].x), bflo(pa[dr].y), bfhi(pa[dr].y)};
            float ow[4], okt[4], oka[4];
#pragma unroll
            for (int e = 0; e < 4; ++e) {
                const float ew = 0.60653066f * sigm(w04[e] + pw4[e]);
                ow[e] = 1.0f - __expf(-ew);
                const float a = sigm(a04[e] + pa4[e]);
                okt[e] = k4[e] * (1.0f + (a - 1.0f) * ka4[e]);
                oka[e] = kk4[e] * a;
                bsum += r4[e] * okt[e] * rk4[e];
            }
            uint2 t; t.x = pack2(ow[0], ow[1]); t.y = pack2(ow[2], ow[3]); *(uint2*)((bf16_t*)(p.ws + OFF_RWP + (size_t)(2 + dr) * ARR) + o) = t;
            t.x = pack2(okt[0], okt[1]); t.y = pack2(okt[2], okt[3]); *(uint2*)((bf16_t*)(p.ws + OFF_RWP + (size_t)(4 + dr) * ARR) + o) = t;
            t.x = pack2(oka[0], oka[1]); t.y = pack2(oka[2], oka[3]); *(uint2*)((bf16_t*)(p.ws + OFF_RWP + (size_t)(6 + dr) * ARR) + o) = t;
        }
        bsum = red16(bsum);
        if (l16 == 0) CB[(size_t)row * 6 + h] = bsum;
    }
}

DI void ph_rwscan(const P& p, float* lds) {
    float* buf = lds;
    float* ybuf = lds + 24576;
    float* ydummy = lds + 26624;
    const int tid = tidx();
    for (int cb = bidx(); cb < 192; cb += gridDim.x) {
        const int it = (((cb & 7) * 6 + (cb >> 5)) << 2) | ((cb >> 3) & 3);
        const int rg = it & 3, dr = (it >> 2) & 1, h = (it >> 3) % 6, b = it / 48;
        __syncthreads();
        const bool consumer = tid < 256;
        const int rr = (tid >> 4) & 15, kc = tid & 15, lt = tid & 255;
        const unsigned char* rwp = p.ws + OFF_RWP;
        bf16_t* YD = (bf16_t*)(p.ws + OFF_R2 + (size_t)dr * ARR);
        f32x2 S01 = (f32x2){0.f, 0.f}, S23 = (f32x2){0.f, 0.f};
        uint4 rawA[6], rawB[6];
        const int lslot = lt >> 3, lpart = lt & 7;
        auto issue = [&](int j, uint4 (&raw)[6]) {
            const int row = rw_row(32 * j + lslot, dr, b);
            const size_t off = ((size_t)row * 384 + h * 64 + lpart * 8) * 2;
            raw[0] = *(const uint4*)(rwp + (size_t)(2 + dr) * ARR + off);
            raw[1] = *(const uint4*)(rwp + ARR + off);
            raw[2] = *(const uint4*)(rwp + (size_t)(6 + dr) * ARR + off);
            raw[3] = *(const uint4*)(rwp + (size_t)(4 + dr) * ARR + off);
            raw[4] = *(const uint4*)(rwp + off);
            raw[5] = *(const uint4*)(p.ws + OFF_V + off);
        };
        auto commit = [&](int bsel, const uint4 (&raw)[6]) {
            float* dst = buf + bsel * 12288 + lslot * 384 + lpart * 8;
#pragma unroll
            for (int a = 0; a < 6; ++a) {
                f32x4 f0 = (f32x4){bflo(raw[a].x), bfhi(raw[a].x), bflo(raw[a].y), bfhi(raw[a].y)}, f1 = (f32x4){bflo(raw[a].z), bfhi(raw[a].z), bflo(raw[a].w), bfhi(raw[a].w)};
                if (a == 0) { f0 = 1.0f - f0; f1 = 1.0f - f1; }
                *(f32x4*)(dst + a * 64) = f0; *(f32x4*)(dst + a * 64 + 4) = f1;
            }
        };
        auto flush = [&](int j) {
#pragma unroll
            for (int e = 0; e < 2; ++e) {
                const int q = lt + 256 * e; const int slot = q >> 4, r16 = q & 15;
                const int row = rw_row(32 * j + slot, dr, b);
                const f32x2 yh = *(const f32x2*)(ybuf + (j & 1) * 1024 + (slot * 16 + r16) * 2);
                YD[(size_t)row * 384 + h * 64 + rg * 16 + r16] = f2bf(yh[0] + yh[1]);
            }
        };
        if (!consumer) { issue(0, rawA); commit(0, rawA); issue(1, rawA); }
        asm volatile("s_waitcnt lgkmcnt(0)" ::: "memory"); __builtin_amdgcn_s_barrier(); asm volatile("" ::: "memory");
        for (int j = 0; j < 136; ++j) {
            if (consumer) {
                const float* bb = buf + (j & 1) * 12288; float* yb = ybuf + (j & 1) * 1024;
                const float* tb0 = bb + kc * 4;
                f32x4 w4 = *(const f32x4*)(tb0), kk4 = *(const f32x4*)(tb0 + 64), kka4 = *(const f32x4*)(tb0 + 128), kt4 = *(const f32x4*)(tb0 + 192), r4 = *(const f32x4*)(tb0 + 256);
                float vv = bb[320 + rg * 16 + rr];
                float* yw = ((kc & 7) == 0) ? (yb + rr * 2 + (kc >> 3)) : (ydummy + tid);
                float yp = 0.f;
#pragma unroll
                for (int i = 0; i < 32; ++i) {
                    const int in = i < 31 ? i + 1 : 31;
                    const float* tn = bb + in * 384 + kc * 4;
                    const f32x4 nw4 = *(const f32x4*)(tn), nkk4 = *(const f32x4*)(tn + 64), nkka4 = *(const f32x4*)(tn + 128), nkt4 = *(const f32x4*)(tn + 192), nr4 = *(const f32x4*)(tn + 256);
                    const float nvv = bb[in * 384 + 320 + rg * 16 + rr];
                    f32x2 td = S01 * (f32x2){kk4[0], kk4[1]}; td = S23 * (f32x2){kk4[2], kk4[3]} + td;
                    float d = td[0] + td[1];
                    const f32x2 kv01 = (f32x2){kt4[0], kt4[1]} * vv, kv23 = (f32x2){kt4[2], kt4[3]} * vv;
                    d += dppf<0xB1>(d); yp += dppf<0xB1>(yp);
                    d += dppf<0x4E>(d); yp += dppf<0x4E>(yp);
                    d += dppf<0x141>(d); yp += dppf<0x141>(yp);
                    d += dppf<0x128>(d);
                    if (i > 0) yw[(i - 1) * 32] = yp;
                    const float sa = -d;
                    S01 = S01 * (f32x2){w4[0], w4[1]} + ((f32x2){kka4[0], kka4[1]} * sa + kv01);
                    S23 = S23 * (f32x2){w4[2], w4[3]} + ((f32x2){kka4[2], kka4[3]} * sa + kv23);
                    f32x2 ty = S01 * (f32x2){r4[0], r4[1]}; ty = S23 * (f32x2){r4[2], r4[3]} + ty;
                    yp = ty[0] + ty[1];
                    w4 = nw4; kk4 = nkk4; kka4 = nkka4; kt4 = nkt4; r4 = nr4; vv = nvv;
                }
                yp += dppf<0xB1>(yp); yp += dppf<0x4E>(yp); yp += dppf<0x141>(yp);
                yw[31 * 32] = yp;
            } else {
                if (j + 2 < 136) issue(j + 2, rawB);
                if (j + 1 < 136) commit((j + 1) & 1, rawA);
                if (j > 0) flush(j - 1);
#pragma unroll
                for (int e = 0; e < 6; ++e) rawA[e] = rawB[e];
            }
            asm volatile("s_waitcnt lgkmcnt(0)" ::: "memory"); __builtin_amdgcn_s_barrier(); asm volatile("" ::: "memory");
        }
        if (!consumer) flush(135);
    }
}


DI void ph_rwscan3(const P& p, float* lds) {
    float* buf = lds;
    float* ybuf = lds + 24576;
    float* ydummy = lds + 25600;
    float* abuf = lds + 26624;
    const int tid = tidx();
    for (int it = bidx(); it < 192; it += gridDim.x) {
        const int rg = it & 3, dr = (it >> 2) & 1, h = (it >> 3) % 6, b = it / 48;
        __syncthreads();
        const bool consumer = tid < 256;
        const int rr = (tid >> 4) & 15, kc = tid & 15, lt = tid & 255;
        const int lslot = lt >> 3, lpart = lt & 7;
        const unsigned char* rwp = p.ws + OFF_RWP;
        bf16_t* YD = (bf16_t*)(p.ws + OFF_R2 + (size_t)dr * ARR);
        f32x2 S01 = (f32x2){0.f, 0.f}, S23 = (f32x2){0.f, 0.f};
        float Dred = 0.f, sa_prev = 0.f, vv_prev = 0.f, a_cur = 0.f, b_cur = 0.f;
        uint4 rawA[6], rawB[6];
        auto issue = [&](int j, uint4 (&raw)[6]) {
            const int step = 32 * j + lslot;
            const int row = rw_row(step, dr, b);
            const int rown = rw_row(step < 4351 ? step + 1 : step, dr, b);
            const size_t off = ((size_t)row * 384 + h * 64 + lpart * 8) * 2, offn = ((size_t)rown * 384 + h * 64 + lpart * 8) * 2;
            raw[0] = *(const uint4*)(rwp + (size_t)(2 + dr) * ARR + off);
            raw[1] = *(const uint4*)(rwp + ARR + offn);
            raw[2] = *(const uint4*)(rwp + (size_t)(6 + dr) * ARR + off);
            raw[3] = *(const uint4*)(rwp + (size_t)(4 + dr) * ARR + off);
            raw[4] = *(const uint4*)(rwp + off);
            raw[5] = *(const uint4*)(p.ws + OFF_V + off);
        };
        auto commit = [&](int bsel, const uint4 (&raw)[6]) {
            f32x4 f[6][2];
#pragma unroll
            for (int a = 0; a < 6; ++a) { f[a][0] = (f32x4){bflo(raw[a].x), bfhi(raw[a].x), bflo(raw[a].y), bfhi(raw[a].y)}; f[a][1] = (f32x4){bflo(raw[a].z), bfhi(raw[a].z), bflo(raw[a].w), bfhi(raw[a].w)}; }
            f[0][0] = 1.0f - f[0][0]; f[0][1] = 1.0f - f[0][1];
            const f32x4 wk0 = f[0][0] * f[1][0], wk1 = f[0][1] * f[1][1];
            const f32x4 pa = f[2][0] * f[1][0] + f[2][1] * f[1][1], pb = f[3][0] * f[1][0] + f[3][1] * f[1][1];
            float an = (pa[0] + pa[1]) + (pa[2] + pa[3]), bn = (pb[0] + pb[1]) + (pb[2] + pb[3]);
            an += dppf<0xB1>(an); bn += dppf<0xB1>(bn); an += dppf<0x4E>(an); bn += dppf<0x4E>(bn); an += dppf<0x141>(an); bn += dppf<0x141>(bn);
            float* dst = buf + bsel * 12288 + lslot * 384 + lpart * 8;
            *(f32x4*)(dst) = f[0][0]; *(f32x4*)(dst + 4) = f[0][1];
            *(f32x4*)(dst + 64) = wk0; *(f32x4*)(dst + 68) = wk1;
            *(f32x4*)(dst + 128) = f[2][0]; *(f32x4*)(dst + 132) = f[2][1];
            *(f32x4*)(dst + 192) = f[3][0]; *(f32x4*)(dst + 196) = f[3][1];
            *(f32x4*)(dst + 256) = f[4][0]; *(f32x4*)(dst + 260) = f[4][1];
            *(f32x4*)(dst + 320) = f[5][0]; *(f32x4*)(dst + 324) = f[5][1];
            if (lpart == 0) { abuf[(bsel * 32 + lslot) * 2] = an; abuf[(bsel * 32 + lslot) * 2 + 1] = bn; }
        };
        auto flush = [&](int j) {
#pragma unroll
            for (int e = 0; e < 2; ++e) {
                const int q = lt + 256 * e; const int slot = q >> 4, r16 = q & 15;
                const int row = rw_row(32 * j + slot, dr, b);
                YD[(size_t)row * 384 + h * 64 + rg * 16 + r16] = f2bf(ybuf[(j & 1) * 512 + slot * 16 + r16]);
            }
        };
        if (!consumer) { issue(0, rawA); commit(0, rawA); issue(1, rawA); }
        lds_barrier();
        for (int j = 0; j < 136; ++j) {
            if (consumer) {
                const float* bb = buf + (j & 1) * 12288; float* yb = ybuf + (j & 1) * 512; const float* ab = abuf + (j & 1) * 64;
                const float* tb0 = bb + kc * 4;
                f32x4 w4 = *(const f32x4*)(tb0), wk4 = *(const f32x4*)(tb0 + 64), kka4 = *(const f32x4*)(tb0 + 128), kt4 = *(const f32x4*)(tb0 + 192), r4 = *(const f32x4*)(tb0 + 256);
                float vv = bb[320 + rg * 16 + rr];
                f32x2 abn = *(const f32x2*)ab;
                float* yw = (kc == 0) ? (yb + rr) : (ydummy + tid);
                float yp = 0.f;
#pragma unroll 8
                for (int i = 0; i < 32; ++i) {
                    const int in = i < 31 ? i + 1 : 31;
                    const float* tn = bb + in * 384 + kc * 4;
                    const f32x4 nw4 = *(const f32x4*)(tn), nwk4 = *(const f32x4*)(tn + 64), nkka4 = *(const f32x4*)(tn + 128), nkt4 = *(const f32x4*)(tn + 192), nr4 = *(const f32x4*)(tn + 256);
                    const float nvv = bb[in * 384 + 320 + rg * 16 + rr];
                    const f32x2 nabn = *(const f32x2*)(ab + in * 2);
                    const float d = Dred + sa_prev * a_cur + vv_prev * b_cur;
                    const float sa = -d;
                    f32x2 tp = S01 * (f32x2){wk4[0], wk4[1]}; tp = S23 * (f32x2){wk4[2], wk4[3]} + tp;
                    float pn = tp[0] + tp[1];
                    const f32x2 kv01 = (f32x2){kt4[0], kt4[1]} * vv, kv23 = (f32x2){kt4[2], kt4[3]} * vv;
                    S01 = S01 * (f32x2){w4[0], w4[1]} + ((f32x2){kka4[0], kka4[1]} * sa + kv01);
                    S23 = S23 * (f32x2){w4[2], w4[3]} + ((f32x2){kka4[2], kka4[3]} * sa + kv23);
                    pn += dppf<0xB1>(pn); yp += dppf<0xB1>(yp);
                    pn += dppf<0x4E>(pn); yp += dppf<0x4E>(yp);
                    pn += dppf<0x141>(pn); yp += dppf<0x141>(yp);
                    pn += dppf<0x128>(pn); yp += dppf<0x128>(yp);
                    if (i > 0) yw[(i - 1) * 16] = yp;
                    f32x2 ty = S01 * (f32x2){r4[0], r4[1]}; ty = S23 * (f32x2){r4[2], r4[3]} + ty;
                    yp = ty[0] + ty[1];
                    Dred = pn; sa_prev = sa; vv_prev = vv; a_cur = abn[0]; b_cur = abn[1];
                    w4 = nw4; wk4 = nwk4; kka4 = nkka4; kt4 = nkt4; r4 = nr4; vv = nvv; abn = nabn;
                }
                yp = red16(yp);
                yw[31 * 16] = yp;
            } else {
                if (j + 2 < 136) issue(j + 2, rawB);
                if (j + 1 < 136) commit((j + 1) & 1, rawA);
                if (j > 0) flush(j - 1);
#pragma unroll
                for (int e = 0; e < 6; ++e) rawA[e] = rawB[e];
            }
            lds_barrier();
        }
        if (!consumer) flush(135);
    }
}

template <bool RO> DI void ph_s5(const P& p, int l, float* lds, int bstart, int bstride) {
    const int tid = tidx(), lane = tid & 63, wv = tid >> 6, fr = lane & 15, fq = lane >> 4;
    float* BU = lds + wv * 2048;
    bf16_t* Hb = (bf16_t*)(lds + 8 * 2048) + wv * (16 * 136);
    float* ysum = lds + 8 * 2048 + 8 * 16 * 136 / 2;
    const bf16_t* ZS5 = (const bf16_t*)(p.ws + OFF_ZS5);
    bf16_t* G5 = (bf16_t*)(p.ws + OFF_G5);
    float2* ST = (float2*)(p.ws + OFF_S5ST);
    const bf16_t* s5w = (const bf16_t*)(p.ws + OFF_S5W);
    int cur_gq = -1;
    float ar = 0.f, ai = 0.f, fr_ = 0.f, fi_ = 0.f;
    bf16x8 bfrag[8]; bf16x8 cfrag[4];
    for (int it = bstart; it < 1088; it += bstride) {
        const int gq = it & 3; const int rem = it >> 2; const int cidx = rem % 68, b = rem / 68;
        const int gl_ = wv & 3, dr = wv >> 2, g = gq * 4 + gl_, dg = dr * 16 + g;
        const int row0 = cidx < 4 ? NLAT + b * 256 + cidx * 64 : b * 4096 + (cidx - 4) * 64;
        lds_barrier();
        if (RO) {
#pragma unroll
            for (int i = 0; i < 8; ++i) ysum[tid + 512 * i] = 0.f;
        }
        if (gq != cur_gq) {
            cur_gq = gq;
            s5_abar(p, l, dr, g, lane, ar, ai, fr_, fi_);
#pragma unroll
            for (int nt = 0; nt < 8; ++nt) bfrag[nt] = *(const bf16x8*)(s5w + (size_t)dg * 4096 + (16 * nt + fr) * 32 + 8 * fq);
            if (RO) {
#pragma unroll
                for (int ks = 0; ks < 4; ++ks) cfrag[ks] = *(const bf16x8*)(s5w + 32 * 4096 + (size_t)dg * 2048 + fr * 128 + 32 * ks + 8 * fq);
            }
        }
        float hr = 0.f, hi = 0.f;
        const size_t sidx = ((size_t)((b * 2 + dr) * 68 + cidx) * 16 + g) * 64 + lane;
        if (RO) { const float2 s0 = ST[sidx]; hr = s0.x; hi = s0.y; }
        lds_barrier();
        bf16x8 afr[4];
#pragma unroll
        for (int sb = 0; sb < 4; ++sb) {
            const int s_a = 16 * sb + fr; const int t_a = dr ? 63 - s_a : s_a;
            afr[sb] = (bf16x8){0, 0, 0, 0, 0, 0, 0, 0};
            if (fq < 2) afr[sb] = *(const bf16x8*)(ZS5 + (size_t)(row0 + t_a) * 256 + g * 16 + 8 * fq);
        }
#pragma unroll
        for (int sb = 0; sb < 4; ++sb) {
            const bf16x8 afrag = afr[sb];
#pragma unroll
            for (int nt = 0; nt < 8; ++nt) {
                f32x4 acc = __builtin_amdgcn_mfma_f32_16x16x32_bf16(afrag, bfrag[nt], (f32x4){0.f, 0.f, 0.f, 0.f}, 0, 0, 0);
#pragma unroll
                for (int r = 0; r < 4; ++r) BU[(fq * 4 + r) * 128 + 16 * nt + fr] = acc[r];
            }
            asm volatile("s_waitcnt lgkmcnt(0)" ::: "memory");
            float burv[16], buiv[16];
#pragma unroll
            for (int sl = 0; sl < 16; ++sl) { burv[sl] = BU[sl * 128 + lane]; buiv[sl] = BU[sl * 128 + 64 + lane]; }
#pragma unroll
            for (int sl = 0; sl < 16; ++sl) {
                const float bur = burv[sl], bui = buiv[sl];
                const float nhr = ar * hr - ai * hi + bur, nhi = ar * hi + ai * hr + bui;
                hr = nhr; hi = nhi;
                if (RO) { Hb[sl * 136 + lane] = f2bf(hr); Hb[sl * 136 + 64 + lane] = f2bf(hi); }
            }
            if (RO) {
                asm volatile("s_waitcnt lgkmcnt(0)" ::: "memory");
                f32x4 acc = (f32x4){0.f, 0.f, 0.f, 0.f};
#pragma unroll
                for (int ks = 0; ks < 4; ++ks) acc = __builtin_amdgcn_mfma_f32_16x16x32_bf16(*(const bf16x8*)(Hb + fr * 136 + 32 * ks + 8 * fq), cfrag[ks], acc, 0, 0, 0);
#pragma unroll
                for (int r = 0; r < 4; ++r) { const int s2 = 16 * sb + fq * 4 + r; const int t2 = dr ? 63 - s2 : s2; atomicAdd(&ysum[t2 * 64 + gl_ * 16 + fr], acc[r]); }
                asm volatile("s_waitcnt lgkmcnt(0)" ::: "memory");
            }
        }
        if (!RO) { ST[sidx] = make_float2(hr, hi); }
        else {
            lds_barrier();
            const float* dd = p.s5_d + l * 256 + gq * 64;
#pragma unroll
            for (int i = 0; i < 8; ++i) { const int idx = tid + 512 * i; const int t = idx >> 6, ch = idx & 63;
                const float u = bf2f(ZS5[(size_t)(row0 + t) * 256 + gq * 64 + ch]);
                const float xv = ysum[idx] + dd[ch] * u;
                const float ge = 0.5f * xv * (1.0f + tanh_fast(0.7978845608f * (xv + 0.044715f * xv * xv * xv)));
                G5[(size_t)(row0 + t) * 256 + gq * 64 + ch] = f2bf(ge); }
        }
    }
}

DI void ph_s5carry(const P& p, int l, int bstart, int bstride) {
    float2* ST = (float2*)(p.ws + OFF_S5ST);
    for (int i = bstart * 512 + tidx(); i < 8192; i += bstride * 512) {
        const int pp = i & 63, g = (i >> 6) & 15, dr = (i >> 10) & 1, b = i >> 11;
        float ar, ai, fr, fi; s5_abar(p, l, dr, g, pp, ar, ai, fr, fi);
#pragma unroll
        for (int q = 0; q < 6; ++q) { const float nr = ar * ar - ai * ai, ni = 2.0f * ar * ai; ar = nr; ai = ni; }
        float sr = 0.f, si = 0.f;
        for (int k0 = 0; k0 < 68; k0 += 17) {
            float2 Eb[17];
#pragma unroll
            for (int q = 0; q < 17; ++q) { const int k = k0 + q; const int c = dr == 0 ? k : (k < 4 ? 3 - k : 71 - k); Eb[q] = ST[((size_t)((b * 2 + dr) * 68 + c) * 16 + g) * 64 + pp]; }
#pragma unroll
            for (int q = 0; q < 17; ++q) { const int k = k0 + q; const int c = dr == 0 ? k : (k < 4 ? 3 - k : 71 - k);
                ST[((size_t)((b * 2 + dr) * 68 + c) * 16 + g) * 64 + pp] = make_float2(sr, si);
                const float nr = ar * sr - ai * si + Eb[q].x, ni = ar * si + ai * sr + Eb[q].y; sr = nr; si = ni; }
        }
    }
}

DI float hg_lb(const P& p, int l, int dr, int c) {
    if (l == 0) return 0.f;
    const float e0 = __expf(p.hgrn_lb[(0 * 2 + dr) * 384 + c]), e1 = __expf(p.hgrn_lb[(1 * 2 + dr) * 384 + c]);
    return e1 / (e0 + e1);
}
DI void hg_prep(const P& p, int l, int dr, int h, int row_base, int sb, float* pb) {
    const int tid = tidx(); const int st = tid >> 4, c4 = (tid & 15) * 4;
    const int s = 32 * sb + st; const int tl = dr ? 127 - s : s;
    const bf16_t* z = (const bf16_t*)(p.ws + OFF_ZHG) + (size_t)(row_base + tl) * 1920 + h * 64 + c4;
    const uint2 zq = *(const uint2*)z, zi = *(const uint2*)(z + 384), zf = *(const uint2*)(z + 768 + dr * 384);
    const float qv[4] = {bflo(zq.x), bfhi(zq.x), bflo(zq.y), bfhi(zq.y)}, iv[4] = {bflo(zi.x), bfhi(zi.x), bflo(zi.y), bfhi(zi.y)}, fv[4] = {bflo(zf.x), bfhi(zf.x), bflo(zf.y), bfhi(zf.y)};
    f32x4 fo, ko, vo, qo;
#pragma unroll
    for (int e = 0; e < 4; ++e) {
        const float lb = hg_lb(p, l, dr, h * 64 + c4 + e);
        const float ex = __expf(-fv[e]);
        const float sg = 1.0f / (1.0f + ex);
        const float sgn = 1.0f / (1.0f + __expf(fv[e]));
        fo[e] = lb + (1.0f - lb) * sg; ko[e] = (1.0f - lb) * sgn; vo[e] = iv[e]; qo[e] = qv[e] * sigm(qv[e]);
    }
    float* d = pb + st * 256 + c4;
    *(f32x4*)d = fo; *(f32x4*)(d + 64) = ko; *(f32x4*)(d + 128) = vo; *(f32x4*)(d + 192) = qo;
}
DI void ph_hg1(const P& p, int l, float* lds) {
    float* pb = lds;
    const int tid = tidx(), lane = tid & 63, wv = tid >> 6, jj = lane & 7, ig = lane >> 3;
    float* HGST = (float*)(p.ws + OFF_HGST); float* HGF = (float*)(p.ws + OFF_HGF);
    for (int it = bidx(); it < 1632; it += gridDim.x) {
        const int cidx = it % 34; const int rest = it / 34; const int dr = rest & 1, h = (rest >> 1) % 6, b = rest / 12;
        const int row_base = cidx < 2 ? NLAT + b * 256 + cidx * 128 : b * 4096 + (cidx - 2) * 128;
        float S[8], Fp[8];
#pragma unroll
        for (int e = 0; e < 8; ++e) { S[e] = 0.f; Fp[e] = 1.f; }
        for (int sb = 0; sb < 4; ++sb) {
            __syncthreads();
            hg_prep(p, l, dr, h, row_base, sb, pb);
            __syncthreads();
#pragma unroll 4
            for (int st = 0; st < 32; ++st) {
                const float* q = pb + st * 256;
                const f32x4 f0 = *(const f32x4*)(q + ig * 8), f1 = *(const f32x4*)(q + ig * 8 + 4), k0 = *(const f32x4*)(q + 64 + ig * 8), k1 = *(const f32x4*)(q + 64 + ig * 8 + 4);
                const float vj = q[128 + wv * 8 + jj];
#pragma unroll
                for (int e = 0; e < 4; ++e) { S[e] = f0[e] * S[e] + k0[e] * vj; S[4 + e] = f1[e] * S[4 + e] + k1[e] * vj; Fp[e] *= f0[e]; Fp[4 + e] *= f1[e]; }
            }
        }
        const size_t sbase = (size_t)(((b * 6 + h) * 2 + dr) * 34 + cidx);
#pragma unroll
        for (int e = 0; e < 8; ++e) HGST[sbase * 4096 + (ig * 8 + e) * 64 + wv * 8 + jj] = S[e];
        if (wv == 0 && jj == 0) {
#pragma unroll
            for (int e = 0; e < 8; ++e) HGF[sbase * 64 + ig * 8 + e] = Fp[e];
        }
    }
}
DI void ph_hgcarry(const P& p) {
    float* HGST = (float*)(p.ws + OFF_HGST); const float* HGF = (const float*)(p.ws + OFF_HGF);
    for (int idx = bidx() * 512 + tidx(); idx < 196608; idx += gridDim.x * 512) {
        const int j = idx & 63, i = (idx >> 6) & 63, seq = idx >> 12; const int dr = seq & 1;
        float S = 0.f;
        for (int k0 = 0; k0 < 34; k0 += 17) {
            float Eb[17], Fb[17];
#pragma unroll
            for (int q = 0; q < 17; ++q) { const int k = k0 + q; const int c = dr == 0 ? k : (k < 2 ? 1 - k : 35 - k);
                Eb[q] = HGST[(size_t)(seq * 34 + c) * 4096 + i * 64 + j]; Fb[q] = HGF[(size_t)(seq * 34 + c) * 64 + i]; }
#pragma unroll
            for (int q = 0; q < 17; ++q) { const int k = k0 + q; const int c = dr == 0 ? k : (k < 2 ? 1 - k : 35 - k);
                HGST[(size_t)(seq * 34 + c) * 4096 + i * 64 + j] = S; S = Fb[q] * S + Eb[q]; }
        }
    }
}
DI void ph_hg3(const P& p, int l, float* lds, bool skip_ctx) {
    float* pb = lds; float* osum = lds + 8192;
    const int tid = tidx(), lane = tid & 63, wv = tid >> 6, jj = lane & 7, ig = lane >> 3;
    const float* HGST = (const float*)(p.ws + OFF_HGST);
    bf16_t* Y = (bf16_t*)(p.ws + OFF_R1);
    const bf16_t* ZHG = (const bf16_t*)(p.ws + OFF_ZHG);
    for (int it = bidx(); it < 816; it += gridDim.x) {
        const int cidx = it % 34, h = (it / 34) % 6, b = it / 204;
        if (skip_ctx && cidx < 2) continue;
        const int row_base = cidx < 2 ? NLAT + b * 256 + cidx * 128 : b * 4096 + (cidx - 2) * 128;
        for (int dr = 0; dr < 2; ++dr) {
            const size_t sbase = (size_t)(((b * 6 + h) * 2 + dr) * 34 + cidx);
            float S[8];
#pragma unroll
            for (int e = 0; e < 8; ++e) S[e] = HGST[sbase * 4096 + (ig * 8 + e) * 64 + wv * 8 + jj];
            for (int sb = 0; sb < 4; ++sb) {
                __syncthreads();
                hg_prep(p, l, dr, h, row_base, sb, pb);
                __syncthreads();
                const float* qp = pb + ig * 8;
                f32x4 f0 = *(const f32x4*)(qp), f1 = *(const f32x4*)(qp + 4), k0 = *(const f32x4*)(qp + 64), k1 = *(const f32x4*)(qp + 68), q0 = *(const f32x4*)(qp + 192), q1 = *(const f32x4*)(qp + 196);
                float vj = pb[128 + wv * 8 + jj];
#pragma unroll 4
                for (int st = 0; st < 32; ++st) {
                    const int sn = st < 31 ? st + 1 : 31;
                    const float* qn = pb + sn * 256 + ig * 8;
                    const f32x4 nf0 = *(const f32x4*)(qn), nf1 = *(const f32x4*)(qn + 4), nk0 = *(const f32x4*)(qn + 64), nk1 = *(const f32x4*)(qn + 68), nq0 = *(const f32x4*)(qn + 192), nq1 = *(const f32x4*)(qn + 196);
                    const float nvj = pb[sn * 256 + 128 + wv * 8 + jj];
                    float o = 0.f;
#pragma unroll
                    for (int e = 0; e < 4; ++e) { S[e] = f0[e] * S[e] + k0[e] * vj; S[4 + e] = f1[e] * S[4 + e] + k1[e] * vj; o += q0[e] * S[e] + q1[e] * S[4 + e]; }
                    f0 = nf0; f1 = nf1; k0 = nk0; k1 = nk1; q0 = nq0; q1 = nq1; vj = nvj;
                    o += dppf<0x128>(o);
                    o += __shfl_xor(o, 16);
                    o += __shfl_xor(o, 32);
                    const int s = 32 * sb + st; const int tl = dr ? 127 - s : s;
                    if (lane < 8) { float* op = osum + tl * 64 + wv * 8 + jj; if (dr == 0) *op = o; else *op += o; }
                }
            }
        }
        __syncthreads();
        { const int t = tid >> 2, qd = tid & 3;
          const float* op = osum + t * 64 + qd * 16;
          float ov[16]; float ss = 0.f;
#pragma unroll
          for (int q = 0; q < 4; ++q) { const f32x4 o4 = *(const f32x4*)(op + q * 4);
#pragma unroll
              for (int e = 0; e < 4; ++e) { ov[q * 4 + e] = o4[e]; ss += o4[e] * o4[e]; } }
          ss += dppf<0xB1>(ss); ss += dppf<0x4E>(ss);
          const float rs = rsqrtf(ss * (1.0f / 64.0f) + 1e-6f);
          const int row = row_base + t; const int c0 = h * 64 + qd * 16;
          const bf16_t* gz = ZHG + (size_t)row * 1920 + 1536 + c0;
          const uint4 g0 = *(const uint4*)gz, g1 = *(const uint4*)(gz + 8);
          const unsigned gw[8] = {g0.x, g0.y, g0.z, g0.w, g1.x, g1.y, g1.z, g1.w};
          const float* ng = p.hgrn_norm_g + l * 384 + c0;
          unsigned ow[8];
#pragma unroll
          for (int e = 0; e < 8; ++e) {
              const float ga = bflo(gw[e]), gb = bfhi(gw[e]);
              const float oa = ov[2 * e] * rs * ng[2 * e] * (ga * sigm(ga)), ob = ov[2 * e + 1] * rs * ng[2 * e + 1] * (gb * sigm(gb));
              ow[e] = pack2(oa, ob);
          }
          bf16_t* yo = Y + (size_t)row * 1024 + 256 + c0;
          *(uint4*)yo = make_uint4(ow[0], ow[1], ow[2], ow[3]); *(uint4*)(yo + 8) = make_uint4(ow[4], ow[5], ow[6], ow[7]); }
    }
}


constexpr int HS = 72;
constexpr size_t OFF_HGF2 = OFF_HGST + 26738688;
static_assert(OFF_HGF2 + 835584 <= OFF_RWP + 8 * ARR, "ws5");
DI bf16x8 ldfrag(const bf16_t* p) { return *(const bf16x8*)p; }
DI int hgm_rowbase(int cidx, int b) { return cidx < 4 ? NLAT + b * 256 + cidx * 64 : b * 4096 + (cidx - 4) * 64; }

DI void ph_hg1m(const P& p, int l, float* lds) {
    bf16_t* kT = (bf16_t*)lds;
    bf16_t* vT = kT + 64 * HS;
    float* tot = (float*)(vT + 64 * HS);
    const int tid = tidx(), lane = tid & 63, wv = tid >> 6, fr = lane & 15, fq = lane >> 4;
    const int i = lane, o = wv;
    const bf16_t* ZHG = (const bf16_t*)(p.ws + OFF_ZHG);
    bf16_t* ET = (bf16_t*)(p.ws + OFF_HGST); float* HGF = (float*)(p.ws + OFF_HGF2);
    bf16_t* stg = (bf16_t*)(tot + 512);
    const int ls = tid >> 3, lc8 = (tid & 7) * 8;
    uint4 rF, rV, nF, nV;
    auto fetch1 = [&](int it, uint4& xf, uint4& xv) {
        const int cidx = it % 68; const int rest = it / 68; const int dr = rest & 1, h = (rest >> 1) % 6, b = rest / 12;
        const int tl = dr ? 63 - ls : ls;
        const bf16_t* z = ZHG + (size_t)(hgm_rowbase(cidx, b) + tl) * 1920 + h * 64 + lc8;
        xf = *(const uint4*)(z + 768 + dr * 384); xv = *(const uint4*)(z + 384);
    };
    if (bidx() < 3264) fetch1(bidx(), rF, rV);
    for (int it = bidx(); it < 3264; it += gridDim.x) {
        const int cidx = it % 68; const int rest = it / 68; const int dr = rest & 1, h = (rest >> 1) % 6, b = rest / 12;
        const size_t sbase = (size_t)(((b * 6 + h) * 2 + dr) * 68 + cidx);
        const float lb = hg_lb(p, l, dr, h * 64 + i);
        *(uint4*)(stg + ls * 64 + lc8) = rF; *(uint4*)(stg + 4096 + ls * 64 + lc8) = rV;
        if (it + (int)gridDim.x < 3264) fetch1(it + gridDim.x, nF, nV);
        lds_barrier();
        float kv[8], vv[8], G[8];
        float run = 0.f;
#pragma unroll
        for (int e = 0; e < 8; ++e) {
            const float fz = bf2f(stg[(8 * o + e) * 64 + i]); vv[e] = bf2f(stg[4096 + (8 * o + e) * 64 + i]);
            const float sg = frcp(1.0f + __expf(-fz)), sgn = frcp(1.0f + __expf(fz));
            const float f = lb + (1.0f - lb) * sg;
            kv[e] = (1.0f - lb) * sgn;
            run += __logf(f); G[e] = run;
        }
        tot[o * 64 + i] = run;
        lds_barrier();
        float off = 0.f, glast = 0.f;
#pragma unroll
        for (int q = 0; q < 8; ++q) { const float t = tot[q * 64 + i]; if (q < o) off += t; glast += t; }
        unsigned kw[4], vw[4];
#pragma unroll
        for (int e = 0; e < 4; ++e) {
            const float k0 = kv[2 * e] * __expf(glast - (off + G[2 * e])), k1 = kv[2 * e + 1] * __expf(glast - (off + G[2 * e + 1]));
            kw[e] = pack2(k0, k1); vw[e] = pack2(vv[2 * e], vv[2 * e + 1]);
        }
        *(uint4*)(kT + i * HS + 8 * o) = make_uint4(kw[0], kw[1], kw[2], kw[3]);
        *(uint4*)(vT + i * HS + 8 * o) = make_uint4(vw[0], vw[1], vw[2], vw[3]);
        if (o == 0) HGF[sbase * 64 + i] = __expf(glast);
        lds_barrier();
#pragma unroll
        for (int q2 = 0; q2 < 2; ++q2) {
            const int tile = wv * 2 + q2; const int it_ = tile >> 2, jt = tile & 3;
            f32x4 acc = (f32x4){0.f, 0.f, 0.f, 0.f};
#pragma unroll
            for (int ks = 0; ks < 2; ++ks)
                acc = __builtin_amdgcn_mfma_f32_16x16x32_bf16(ldfrag(kT + (16 * it_ + fr) * HS + 32 * ks + 8 * fq), ldfrag(vT + (16 * jt + fr) * HS + 32 * ks + 8 * fq), acc, 0, 0, 0);
            uint2 w; w.x = pack2(acc[0], acc[1]); w.y = pack2(acc[2], acc[3]);
            *(uint2*)(ET + sbase * 4096 + (16 * jt + fr) * 64 + 16 * it_ + fq * 4) = w;
        }
        rF = nF; rV = nV;
    }
}
DI void ph_hgcarrym(const P& p) {
    bf16_t* ST = (bf16_t*)(p.ws + OFF_HGST); const float* HGF = (const float*)(p.ws + OFF_HGF2);
    for (int idx = bidx() * 512 + tidx(); idx < 49152; idx += gridDim.x * 512) {
        const int i4 = (idx & 15) * 4, j = (idx >> 4) & 63, seq = idx >> 10; const int dr = seq & 1;
        f32x4 S = (f32x4){0.f, 0.f, 0.f, 0.f};
        for (int k0 = 0; k0 < 68; k0 += 17) {
            uint2 Eb[17]; f32x4 Fb[17];
#pragma unroll
            for (int q = 0; q < 17; ++q) { const int k = k0 + q; const int c = dr == 0 ? k : (k < 4 ? 3 - k : 71 - k);
                Eb[q] = *(const uint2*)(ST + (size_t)(seq * 68 + c) * 4096 + j * 64 + i4); Fb[q] = *(const f32x4*)(HGF + (size_t)(seq * 68 + c) * 64 + i4); }
#pragma unroll
            for (int q = 0; q < 17; ++q) { const int k = k0 + q; const int c = dr == 0 ? k : (k < 4 ? 3 - k : 71 - k);
                uint2 o; o.x = pack2(S[0], S[1]); o.y = pack2(S[2], S[3]);
                *(uint2*)(ST + (size_t)(seq * 68 + c) * 4096 + j * 64 + i4) = o;
                const f32x4 E = (f32x4){bflo(Eb[q].x), bfhi(Eb[q].x), bflo(Eb[q].y), bfhi(Eb[q].y)};
                S = Fb[q] * S + E; }
        }
    }
}
DI void ph_hg3m(const P& p, int l, float* lds, bool skip_ctx) {
    bf16_t* qP = (bf16_t*)lds;
    bf16_t* qI = qP + 64 * HS;
    bf16_t* kD = qI + 64 * HS;
    bf16_t* kR = kD + 64 * HS;
    bf16_t* vT = kR + 96 * HS;
    bf16_t* aS = vT + 64 * HS;
    float* tot = (float*)(aS + 64 * HS);
    float* osum = tot + 512;
    const int tid = tidx(), lane = tid & 63, wv = tid >> 6, fr = lane & 15, fq = lane >> 4;
    const int i = lane, o = wv, I = wv >> 1;
    const bf16_t* ZHG = (const bf16_t*)(p.ws + OFF_ZHG);
    const bf16_t* ST = (const bf16_t*)(p.ws + OFF_HGST);
    bf16_t* Y = (bf16_t*)(p.ws + OFF_R1);
    const int nitems = skip_ctx ? 1536 : 1632;
    auto decode = [&](int idx, int& cidx, int& h, int& b) {
        if (skip_ctx) { cidx = 4 + (idx & 63); h = (idx >> 6) % 6; b = idx / 384; } else { cidx = idx % 68; h = (idx / 68) % 6; b = idx / 408; }
    };
    bf16_t* stg = (bf16_t*)(osum + 4096);
    const int ls = tid >> 3, lc8 = (tid & 7) * 8;
    uint4 rQ, rF, rV, nQ, nF, nV;
    auto fetch3 = [&](int idx, int dr, uint4& xq, uint4& xf, uint4& xv) {
        int cidx, h, b; decode(idx, cidx, h, b);
        const int tl = dr ? 63 - ls : ls;
        const bf16_t* z = ZHG + (size_t)(hgm_rowbase(cidx, b) + tl) * 1920 + h * 64 + lc8;
        xq = *(const uint4*)z; xf = *(const uint4*)(z + 768 + dr * 384); xv = *(const uint4*)(z + 384);
    };
    if (bidx() < nitems) fetch3(bidx(), 0, rQ, rF, rV);
    for (int it = bidx(); it < nitems; it += gridDim.x) {
        int cidx, h, b; decode(it, cidx, h, b);
        const int row_base = hgm_rowbase(cidx, b);
        lds_barrier();
        for (int q = tid; q < 64 * HS / 2; q += 512) ((unsigned*)aS)[q] = 0u;
        for (int dr = 0; dr < 2; ++dr) {
            const size_t sbase = (size_t)(((b * 6 + h) * 2 + dr) * 68 + cidx);
            const float lb = hg_lb(p, l, dr, h * 64 + i);
            *(uint4*)(stg + ls * 64 + lc8) = rQ; *(uint4*)(stg + 4096 + ls * 64 + lc8) = rF; *(uint4*)(stg + 8192 + ls * 64 + lc8) = rV;
            if (dr == 0) fetch3(it, 1, nQ, nF, nV);
            else if (it + (int)gridDim.x < nitems) fetch3(it + gridDim.x, 0, nQ, nF, nV);
            bf16x8 sfr[2][2];
#pragma unroll
            for (int q2 = 0; q2 < 2; ++q2)
#pragma unroll
                for (int ks = 0; ks < 2; ++ks) sfr[q2][ks] = ldfrag(ST + sbase * 4096 + (16 * ((wv & 1) * 2 + q2) + fr) * 64 + 8 * fq + 32 * ks);
            lds_barrier();
            float kv[8], vv[8], qv[8], G[8];
            float run = 0.f;
#pragma unroll
            for (int e = 0; e < 8; ++e) {
                const int so = (8 * o + e) * 64 + i;
                const float qz = bf2f(stg[so]); const float fz = bf2f(stg[4096 + so]); vv[e] = bf2f(stg[8192 + so]);
                const float sg = frcp(1.0f + __expf(-fz)), sgn = frcp(1.0f + __expf(fz));
                const float f = lb + (1.0f - lb) * sg;
                kv[e] = (1.0f - lb) * sgn; qv[e] = qz * sigm(qz);
                run += __logf(f); G[e] = run;
            }
            tot[o * 64 + i] = run;
            lds_barrier();
            float gb[5]; gb[0] = 0.f;
            float off = 0.f;
#pragma unroll
            for (int q = 0; q < 8; ++q) { const float t = tot[q * 64 + i]; if (q < o) off += t; if (q & 1) gb[(q >> 1) + 1] = 0.f; }
            { float acc2 = 0.f;
#pragma unroll
              for (int q = 0; q < 8; ++q) { acc2 += tot[q * 64 + i]; if (q & 1) gb[(q >> 1) + 1] = acc2; } }
            const float gbI = I == 0 ? gb[0] : I == 1 ? gb[1] : I == 2 ? gb[2] : gb[3];
            const float egb = __expf(gbI);
            unsigned vw[4];
#pragma unroll
            for (int e = 0; e < 8; ++e) {
                const int s = 8 * o + e;
                const float Gs = off + G[e];
                const float ef = __expf(Gs - gbI);
                qI[s * HS + i] = f2bf(qv[e] * ef);
                qP[s * HS + i] = f2bf(qv[e] * ef * egb);
                kD[s * HS + i] = f2bf(kv[e] * frcp(fmaxf(ef, 1e-35f)));
                if (I < 1) kR[(0 + s) * HS + i] = f2bf(kv[e] * __expf(gb[1] - Gs));
                if (I < 2) kR[(16 + s) * HS + i] = f2bf(kv[e] * __expf(gb[2] - Gs));
                if (I < 3) kR[(48 + s) * HS + i] = f2bf(kv[e] * __expf(gb[3] - Gs));
            }
#pragma unroll
            for (int e = 0; e < 4; ++e) vw[e] = pack2(vv[2 * e], vv[2 * e + 1]);
            *(uint4*)(vT + i * HS + 8 * o) = make_uint4(vw[0], vw[1], vw[2], vw[3]);
            lds_barrier();
            for (int tt = wv; tt < 10; tt += 8) {
                const int TI = tt < 1 ? 0 : tt < 3 ? 1 : tt < 6 ? 2 : 3; const int TJ = tt - (TI * (TI + 1)) / 2;
                const int kbase = TI == 1 ? 0 : TI == 2 ? 16 : 48;
                const bf16_t* ap = qI + (16 * TI + fr) * HS + 8 * fq;
                const bf16_t* bp = (TJ == TI) ? kD + (16 * TI + fr) * HS + 8 * fq : kR + (kbase + 16 * TJ + fr) * HS + 8 * fq;
                f32x4 acc = (f32x4){0.f, 0.f, 0.f, 0.f};
#pragma unroll
                for (int ks = 0; ks < 2; ++ks) acc = __builtin_amdgcn_mfma_f32_16x16x32_bf16(ldfrag(ap + 32 * ks), ldfrag(bp + 32 * ks), acc, 0, 0, 0);
#pragma unroll
                for (int r = 0; r < 4; ++r) { const int sl = fq * 4 + r; const float val = (TJ == TI && fr > sl) ? 0.f : acc[r]; aS[(16 * TI + sl) * HS + 16 * TJ + fr] = f2bf(val); }
            }
            lds_barrier();
#pragma unroll
            for (int q2 = 0; q2 < 2; ++q2) {
                const int jt = (wv & 1) * 2 + q2;
                f32x4 acc = (f32x4){0.f, 0.f, 0.f, 0.f};
                const bf16_t* a1 = qP + (16 * I + fr) * HS + 8 * fq;
                const bf16_t* a2 = aS + (16 * I + fr) * HS + 8 * fq; const bf16_t* b2 = vT + (16 * jt + fr) * HS + 8 * fq;
#pragma unroll
                for (int ks = 0; ks < 2; ++ks) acc = __builtin_amdgcn_mfma_f32_16x16x32_bf16(ldfrag(a1 + 32 * ks), sfr[q2][ks], acc, 0, 0, 0);
#pragma unroll
                for (int ks = 0; ks < 2; ++ks) acc = __builtin_amdgcn_mfma_f32_16x16x32_bf16(ldfrag(a2 + 32 * ks), ldfrag(b2 + 32 * ks), acc, 0, 0, 0);
#pragma unroll
                for (int r = 0; r < 4; ++r) { const int s = 16 * I + fq * 4 + r; const int tl = dr ? 63 - s : s; float* op = osum + tl * 64 + 16 * jt + fr; if (dr == 0) *op = acc[r]; else *op += acc[r]; }
            }
            rQ = nQ; rF = nF; rV = nV;
        }
        lds_barrier();
        { const int t = tid >> 3, oc = tid & 7;
          const float* op = osum + t * 64 + oc * 8;
          const f32x4 o0 = *(const f32x4*)op, o1 = *(const f32x4*)(op + 4);
          float ss = o0[0] * o0[0] + o0[1] * o0[1] + o0[2] * o0[2] + o0[3] * o0[3] + o1[0] * o1[0] + o1[1] * o1[1] + o1[2] * o1[2] + o1[3] * o1[3];
          ss += dppf<0xB1>(ss); ss += dppf<0x4E>(ss); ss += dppf<0x141>(ss);
          const float rs = rsqrtf(ss * (1.0f / 64.0f) + 1e-6f);
          const int row = row_base + t; const int c0 = h * 64 + oc * 8;
          const uint4 g0 = *(const uint4*)(ZHG + (size_t)row * 1920 + 1536 + c0);
          const unsigned gw[4] = {g0.x, g0.y, g0.z, g0.w};
          const float* ng = p.hgrn_norm_g + l * 384 + c0;
          const float ov[8] = {o0[0], o0[1], o0[2], o0[3], o1[0], o1[1], o1[2], o1[3]};
          unsigned ow[4];
#pragma unroll
          for (int e = 0; e < 4; ++e) {
              const float ga = bflo(gw[e]), gbv = bfhi(gw[e]);
              ow[e] = pack2(ov[2 * e] * rs * ng[2 * e] * (ga * sigm(ga)), ov[2 * e + 1] * rs * ng[2 * e + 1] * (gbv * sigm(gbv)));
          }
          *(uint4*)(Y + (size_t)row * 1024 + 256 + c0) = make_uint4(ow[0], ow[1], ow[2], ow[3]); }
    }
}

DI void ph_rwread(const P& p, int l, int nrows) {
    const int tid = tidx(), lane = tid & 63, sub = lane >> 4, l16 = lane & 15;
    const bf16_t* GATE = (const bf16_t*)(p.ws + OFF_GATE); const bf16_t* Vv = (const bf16_t*)(p.ws + OFF_V);
    const bf16_t* YF = (const bf16_t*)(p.ws + OFF_R2); const bf16_t* YB = (const bf16_t*)(p.ws + OFF_R2 + ARR);
    const float* CB = (const float*)(p.ws + OFF_CB);
    bf16_t* Y = (bf16_t*)(p.ws + OFF_R1);
    const int ngrp = nrows * 6 / 4, nw = gridDim.x * 8;
    for (int grp0 = bidx() * 8 + (tid >> 6); grp0 < ngrp; grp0 += 2 * nw) {
        uint2 yf[2], yb[2], vx[2], gx[2]; float cb[2]; int srs[2], cs[2]; bool ok[2];
#pragma unroll
        for (int u = 0; u < 2; ++u) {
            const int grp = grp0 + u * nw; ok[u] = grp < ngrp;
            const int task = (ok[u] ? grp : grp0) * 4 + sub; const int sr = task / 6, h = task % 6, c = h * 64 + l16 * 4;
            srs[u] = sr; cs[u] = c;
            const size_t o = (size_t)sr * 384 + c;
            yf[u] = *(const uint2*)(YF + o); yb[u] = *(const uint2*)(YB + o); vx[u] = *(const uint2*)(Vv + o); gx[u] = *(const uint2*)(GATE + o);
            cb[u] = CB[(size_t)sr * 6 + h];
        }
#pragma unroll
        for (int u = 0; u < 2; ++u) {
            const int sr = srs[u], c = cs[u];
            const f32x4 lw = *(const f32x4*)(p.rwkv_ln_w + l * 384 + c), lb4 = *(const f32x4*)(p.rwkv_ln_b + l * 384 + c);
            const float y4[4] = {bflo(yf[u].x) + bflo(yb[u].x), bfhi(yf[u].x) + bfhi(yb[u].x), bflo(yf[u].y) + bflo(yb[u].y), bfhi(yf[u].y) + bfhi(yb[u].y)};
            const float v4[4] = {bflo(vx[u].x), bfhi(vx[u].x), bflo(vx[u].y), bfhi(vx[u].y)}, g4[4] = {bflo(gx[u].x), bfhi(gx[u].x), bflo(gx[u].y), bfhi(gx[u].y)};
            const float mean = red16((y4[0] + y4[1]) + (y4[2] + y4[3])) * (1.0f / 64.0f);
            float d4[4], vs = 0.f;
#pragma unroll
            for (int e = 0; e < 4; ++e) { d4[e] = y4[e] - mean; vs += d4[e] * d4[e]; }
            const float rstd = rsqrtf(red16(vs) * (1.0f / 64.0f) + 64e-5f);
            float o4[4];
#pragma unroll
            for (int e = 0; e < 4; ++e) o4[e] = (d4[e] * rstd * lw[e] + lb4[e] + cb[u] * v4[e]) * g4[e];
            uint2 t; t.x = pack2(o4[0], o4[1]); t.y = pack2(o4[2], o4[3]);
            if (ok[u]) *(uint2*)(Y + (size_t)permrow(sr) * 1024 + 640 + c) = t;
        }
    }
}

DI void ph_final(const P& p) {
    const int tid = tidx(), lane = tid & 63;
    for (int m = bidx() * 8 + (tid >> 6); m < NLAT; m += gridDim.x * 8) {
        float* src = p.out + (size_t)m * 1024;
        f32x4 v[4]; float ss = 0.f;
#pragma unroll
        for (int j = 0; j < 4; ++j) { v[j] = *(const f32x4*)(src + j * 256 + lane * 4); ss += v[j][0] * v[j][0] + v[j][1] * v[j][1] + v[j][2] * v[j][2] + v[j][3] * v[j][3]; }
        ss = wave_sum(ss);
        const float rstd = rsqrtf(ss * (1.0f / 1024.0f) + 1e-6f);
#pragma unroll
        for (int j = 0; j < 4; ++j) { const int col = j * 256 + lane * 4; const f32x4 g4 = *(const f32x4*)(p.norm_f_g + col); *(f32x4*)(src + col) = v[j] * rstd * g4; }
    }
}


#define XB_TMO      128
#define XB_XCNT(j)  (256  + 64 * (j))
#define XB_XSUB(j)  (1280 + 64 * (j))
#define XB_XGEN(j)  (2304 + 64 * (j))
#define XB_TOP      3328
#define XB_TOPGEN   3392
#define XCD_BAR_WORDS 3456
#define XB_SPIN_CAP (1u << 18)
#define LAS __attribute__((address_space(3)))
DI unsigned xb_ld(unsigned* p)              { return __hip_atomic_load(p, __ATOMIC_RELAXED, __HIP_MEMORY_SCOPE_AGENT); }
DI unsigned xb_add(unsigned* p, unsigned v) { return __hip_atomic_fetch_add(p, v, __ATOMIC_RELAXED, __HIP_MEMORY_SCOPE_AGENT); }
DI unsigned xb_xcc_id() { return (unsigned)__builtin_amdgcn_s_getreg((3 << 11) | 20) & 0xFu; }
#define XB_SPIN(cond, bar) do { unsigned _sp = 0; while (cond) { __builtin_amdgcn_s_sleep(1); \
    if ((++_sp & 255u) == 0u) { if (xb_ld(&(bar)[XB_TMO])) break; if (_sp > XB_SPIN_CAP) { atomicAdd(&(bar)[XB_TMO], 1u); break; } } } } while (0)
struct XcdBarrier { unsigned* bar; unsigned x; volatile LAS unsigned* st; };
DI XcdBarrier xcd_barrier_post(unsigned* bar, volatile LAS unsigned* st) {
    XcdBarrier b; b.bar = bar; b.x = xb_xcc_id(); b.st = st;
    if (threadIdx.x == 0) (void)xb_add(&bar[XB_XCNT(b.x)], 1u);
    return b;
}
DI void xcd_barrier_complete(unsigned* bar, unsigned x, unsigned& nloc, unsigned& nx) {
    const unsigned G = gridDim.x * gridDim.y * gridDim.z;
    unsigned sum, cnt, mine, sp = 0u;
    for (;;) {
        sum = 0u; cnt = 0u; mine = 0u;
#pragma unroll
        for (unsigned j = 0; j < 16; ++j) { const unsigned c = xb_ld(&bar[XB_XCNT(j)]); sum += c; cnt += (c > 0u) ? 1u : 0u; mine = (j == x) ? c : mine; }
        if (sum == G) break;
        __builtin_amdgcn_s_sleep(1);
        if ((++sp & 255u) == 0u) { if (xb_ld(&bar[XB_TMO])) break; if (sp > XB_SPIN_CAP) { atomicAdd(&bar[XB_TMO], 1u); break; } }
    }
    nloc = mine > 0u ? mine : 1u; nx = cnt > 0u ? cnt : 1u;
}
DI void xcd_barrier(const XcdBarrier& b) {
    asm volatile("s_waitcnt vmcnt(0)" ::: "memory");
    __syncthreads();
    if (threadIdx.x == 0) {
        unsigned* bar = b.bar;
        __builtin_amdgcn_s_waitcnt(0);
        unsigned nloc = b.st[0], nx = b.st[1];
        if (nloc == 0u) { xcd_barrier_complete(bar, b.x, nloc, nx); b.st[0] = nloc; b.st[1] = nx; }
        const unsigned old = xb_add(&bar[XB_XSUB(b.x)], 1u);
        const unsigned gen = old / nloc;
        if (old + 1u == (gen + 1u) * nloc) {
            __builtin_amdgcn_fence(__ATOMIC_RELEASE, "agent");
            asm volatile("s_waitcnt vmcnt(0)" ::: "memory");
            const unsigned og = xb_add(&bar[XB_TOP], 1u);
            const unsigned tg = og / nx;
            if (og + 1u == (tg + 1u) * nx) xb_add(&bar[XB_TOPGEN], 1u);
            else XB_SPIN(xb_ld(&bar[XB_TOPGEN]) == tg, bar);
            __builtin_amdgcn_fence(__ATOMIC_ACQUIRE, "agent");
            xb_add(&bar[XB_XGEN(b.x)], 1u);
            asm volatile("s_waitcnt vmcnt(0)" ::: "memory");
        } else {
            XB_SPIN(xb_ld(&bar[XB_XGEN(b.x)]) == gen, bar);
            __builtin_amdgcn_fence(__ATOMIC_ACQUIRE, "agent");
            asm volatile("s_waitcnt vmcnt(0)" ::: "memory");
        }
    }
    __syncthreads();
}

DI void sub_barrier(unsigned* ctr, unsigned target) {
    asm volatile("s_waitcnt vmcnt(0)" ::: "memory");
    __syncthreads();
    if (threadIdx.x == 0) {
        __builtin_amdgcn_fence(__ATOMIC_RELEASE, "agent");
        asm volatile("s_waitcnt vmcnt(0)" ::: "memory");
        (void)xb_add(ctr, 1u);
        unsigned sp = 0;
        while (xb_ld(ctr) < target) { __builtin_amdgcn_s_sleep(2); if (++sp > (1u << 22)) break; }
        __builtin_amdgcn_fence(__ATOMIC_ACQUIRE, "agent");
        asm volatile("s_waitcnt vmcnt(0)" ::: "memory");
    }
    __syncthreads();
}


#if defined(__HIP_DEVICE_COMPILE__)
DI P ldp() { unsigned long long k = (unsigned long long)__builtin_amdgcn_kernarg_segment_ptr(); asm volatile("" : "+s"(k)); return *(const __attribute__((address_space(4))) P*)k; }
#else
__device__ P ldp();
#endif
template <int MODE> DI void run_gemm(PG8_LAS unsigned char* lds, const bf16_t* A, const bf16_t* Bt, int M, int N, int K, const Epi<MODE>& E, int gsz = -1, int gidx = -1) {
    asm volatile("" : "+s"(M), "+s"(N), "+s"(K));
    pg8::StaticOrder S; S.init(M, N, gsz < 0 ? (int)gridDim.x : gsz, gidx < 0 ? (int)bidx() : gidx);
    pg8::Gemm g; g.A = A; g.Bt = Bt; g.M = M; g.N = N; g.K = K; g.lda = K; g.ldb = K; g.tps = 1 << 20;
    pg8::gemm_phase(lds, g, S, E);
}

template <int MODE> DI void run_gemm_split(PG8_LAS unsigned char* lds, const bf16_t* A, const bf16_t* Bt, int rows_real, int N, int K, int nslice, int ld, const Epi<MODE>& E) {
    int M = rows_real * nslice;
    asm volatile("" : "+s"(M), "+s"(N), "+s"(K), "+s"(ld));
    pg8::StaticOrder S; S.init(M, N, (int)gridDim.x, (int)bidx());
    pg8::Gemm g; g.A = A; g.Bt = Bt; g.M = M; g.N = N; g.K = K; g.lda = ld; g.ldb = ld; g.tps = rows_real / 256;
    pg8::gemm_phase(lds, g, S, E);
}

__global__ void __launch_bounds__(512, 2) mega(P p_unused) {
    extern __shared__ __attribute__((aligned(16))) unsigned char shm[];
    cg::grid_group grid = cg::this_grid();
    __shared__ uint4 xb_words;
    if (threadIdx.x == 0) xb_words = make_uint4(0u, 0u, 0u, 0u);
    __syncthreads();
    const XcdBarrier xb = xcd_barrier_post((unsigned*)(ldp().ws + OFF_BAR), (volatile LAS unsigned*)&xb_words);
    float* lds = (float*)shm;
    PG8_LAS unsigned char* lds3 = (PG8_LAS unsigned char*)shm;
#define H ((const bf16_t*)(ldp().ws + OFF_R1))
#define WT ((const bf16_t*)(ldp().ws + OFF_R3))
#define WT_OUT (WT + 3840 * 1024)
#define WT_FF1 (WT + 3840 * 1024 + 1024 * 1024)
#define WT_FF2 (WT + 3840 * 1024 + 1024 * 1024 + 4096 * 1024)
#define xc ((float*)(ldp().ws + OFF_XC))
#define mod ((const float*)(ldp().ws + OFF_MOD))

    REP(512) { ph_mods(ldp(), lds);
    ph_convert(ldp(), 0, lds, 0); }
    grid.sync();
    for (int l = 0; l < 2; ++l) {
        const int mrows = l == 0 ? NTOK : NLAT;
        if (l == 1) ph_convert(ldp(), 1, lds, 0);
        ph_norm(ldp(), l, 0, NTOK);
        xcd_barrier(xb);
        { Epi<7> E{}; E.o0 = (bf16_t*)(ldp().ws + OFF_R2); E.o1 = (bf16_t*)(ldp().ws + OFF_ZS5); E.o2 = (bf16_t*)(ldp().ws + OFF_ZHG); run_gemm<7>(lds3, H, WT, NTOK, 3840, 1024, E); }
        xcd_barrier(xb);
        ph_hg1m(ldp(), l, lds);
        xcd_barrier(xb);
        ph_hgcarrym(ldp());
        ph_s5<false>(ldp(), l, lds, bidx(), gridDim.x);
        xcd_barrier(xb);
        ph_hg3m(ldp(), l, lds, l == 1);
        if (gridDim.x >= 32) { if (bidx() >= (int)gridDim.x - 16) ph_s5carry(ldp(), l, bidx() - ((int)gridDim.x - 16), 16); }
        else ph_s5carry(ldp(), l, bidx(), gridDim.x);
        xcd_barrier(xb);
        ph_rwp1(ldp(), l, lds);
        xcd_barrier(xb);
        { Epi<4> E{}; E.o0 = (bf16_t*)(ldp().ws + OFF_R2); E.o1 = (bf16_t*)(ldp().ws + OFF_GATE); run_gemm<4>(lds3, (const bf16_t*)(ldp().ws + OFF_AUXA), (const bf16_t*)(ldp().ws + OFF_WAUX), NTOK, 2048, 384, E); }
        xcd_barrier(xb);
        ph_rwp2(ldp(), l);
        xcd_barrier(xb);
        ph_rwscan(ldp(), lds);
        const bool s5_in_c = gridDim.x > 192;
        if (s5_in_c) {
            if (bidx() >= 192) {
                const int hb = bidx() - 192, nh = gridDim.x - 192;
                unsigned* ctr = (unsigned*)(ldp().ws + OFF_BAR);
                ph_s5<true>(ldp(), l, lds, hb, nh);
                sub_barrier(ctr, (unsigned)((l + 1) * nh));
                { Epi<5> E{}; E.o0 = (bf16_t*)(ldp().ws + OFF_R1); E.o1 = (bf16_t*)(ldp().ws + OFF_G5); E.gate = ldp().s5_b_glu + l * 256; run_gemm<5>(lds3, (const bf16_t*)(ldp().ws + OFF_G5), (const bf16_t*)(ldp().ws + OFF_WGLU), mrows, 256, 256, E, nh, hb); }
            }
        } else ph_s5<true>(ldp(), l, lds, bidx(), gridDim.x);
        xcd_barrier(xb);
        ph_rwread(ldp(), l, l == 0 ? NTOK : NLAT);
        if (!s5_in_c) { Epi<5> E{}; E.o0 = (bf16_t*)(ldp().ws + OFF_R1); E.o1 = (bf16_t*)(ldp().ws + OFF_G5); E.gate = ldp().s5_b_glu + l * 256; run_gemm<5>(lds3, (const bf16_t*)(ldp().ws + OFF_G5), (const bf16_t*)(ldp().ws + OFF_WGLU), mrows, 256, 256, E); }
        xcd_barrier(xb);
        ph_convert(ldp(), l, lds, 1);
        if (l == 0) { Epi<6> E{}; E.xout_lat = (float*)(ldp().ws + OFF_R2);
          run_gemm_split<6>(lds3, H + (size_t)NLAT * 1024, WT_OUT, 1024, 1024, 256, 4, 1024, E); }
        { Epi<2> E{}; E.xin_lat = l == 0 ? ldp().x : ldp().out; E.xout_lat = ldp().out; E.xin_ctx = l == 0 ? ldp().ctx : xc; E.xout_ctx = xc; E.gate = mod + (size_t)l * 5 * 6144 + 2 * 1024;
          run_gemm<2>(lds3, H, WT_OUT, NLAT, 1024, 1024, E); }
        xcd_barrier(xb);
        REP(64) ph_norm(ldp(), l, 1, mrows);
        xcd_barrier(xb);
        REP(2048) if (PHM & 2048) { Epi<3> E{}; E.o0 = (bf16_t*)(ldp().ws + OFF_HID); run_gemm<3>(lds3, H, WT_FF1, mrows, 4096, 1024, E); }
        xcd_barrier(xb);
        if (l == 0) { Epi<6> E{}; E.xout_lat = (float*)(ldp().ws + OFF_R2);
          run_gemm_split<6>(lds3, (const bf16_t*)(ldp().ws + OFF_HID) + (size_t)NLAT * 4096, WT_FF2, 1024, 1024, 512, 8, 4096, E); }
        { Epi<2> E{}; E.xin_lat = ldp().out; E.xout_lat = ldp().out; E.xin_ctx = xc; E.xout_ctx = xc; E.gate = mod + (size_t)l * 5 * 6144 + 5 * 1024;
          run_gemm<2>(lds3, (const bf16_t*)(ldp().ws + OFF_HID), WT_FF2, NLAT, 1024, 4096, E); }
        xcd_barrier(xb);
    }
    ph_final(ldp());
#undef H
#undef WT
#undef WT_OUT
#undef WT_FF1
#undef WT_FF2
#undef xc
#undef mod
}

extern "C" void kernel_launch(void* const* d_in, const int* in_sizes, int n_in, void* d_out, int out_size, void* d_ws, size_t ws_size, hipStream_t stream) {
    P p{};
    const float** f = (const float**)&p;
    for (int i = 0; i < 36; ++i) f[i] = (const float*)d_in[i];
    p.out = (float*)d_out; p.ws = (unsigned char*)d_ws;
    static int grid_blocks = 0;
    if (!grid_blocks) {
        int dev = 0, cus = 0, per_cu = 0;
        hipGetDevice(&dev);
        hipDeviceGetAttribute(&cus, hipDeviceAttributeMultiprocessorCount, dev);
        hipFuncSetAttribute((const void*)mega, hipFuncAttributeMaxDynamicSharedMemorySize, LDS_BYTES);
        hipOccupancyMaxActiveBlocksPerMultiprocessor(&per_cu, mega, 512, LDS_BYTES);
        if (per_cu < 1) per_cu = 1;
        grid_blocks = cus * per_cu;
        if (grid_blocks > 256) grid_blocks = 256;
    }
    if (ws_size < OFF_BAR + 3456 * 4) fprintf(stderr, "workspace too small: %zu < %zu\n", ws_size, (size_t)WS_NEEDED);
    hipMemsetAsync((unsigned char*)d_ws + OFF_BAR, 0, 3456 * 4, stream);
    void* args[] = {&p};
    hipError_t e = hipLaunchCooperativeKernel((void*)mega, dim3(grid_blocks), dim3(512), args, LDS_BYTES, stream);
    if (e != hipSuccess) fprintf(stderr, "cooperative launch failed: %s (grid %d)\n", hipGetErrorString(e), grid_blocks);
}
```

```cpp
#include <hip/hip_runtime.h>
#include <hip/hip_cooperative_groups.h>
#include <stdio.h>
namespace cg = cooperative_groups;

#define DI __device__ __forceinline__
typedef unsigned short bf16_t;
typedef float f32x4 __attribute__((ext_vector_type(4)));
typedef float f32x2 __attribute__((ext_vector_type(2)));
typedef short bf16x8 __attribute__((ext_vector_type(8)));

constexpr int NTOK = 17408, NLAT = 16384;
constexpr int LDS_BYTES = 131072;
#ifndef PHM
#define PHM 0xFFFF
#endif
#ifndef REPM
#define REPM 0
#endif
#define REP(bit) for (int _r = 0; _r < ((REPM & (bit)) ? 2 : 1); ++_r)

constexpr size_t OFF_XC = 0;
constexpr size_t OFF_MOD = 4194304;
constexpr size_t OFF_CB = OFF_MOD + 245760;
constexpr size_t OFF_S5ST = OFF_CB + 417792;
constexpr size_t OFF_HGF = OFF_S5ST + 4456448;
constexpr size_t OFF_R1 = OFF_HGF + 417792;
constexpr size_t OFF_R2 = OFF_R1 + 35651584;
constexpr size_t OFF_R3 = OFF_R2 + 53477376;
constexpr size_t OFF_R4 = OFF_R3 + 26738688;
constexpr size_t ARR = 13369344;
constexpr size_t OFF_V = OFF_R4;
constexpr size_t OFF_ZS5 = OFF_V + ARR;
constexpr size_t OFF_AUXA = OFF_ZS5 + 8912896;
constexpr size_t OFF_G5 = OFF_AUXA + 4456448;
constexpr size_t OFF_RWP = OFF_G5 + 8912896;
constexpr size_t OFF_ZHG = OFF_RWP;
constexpr size_t OFF_HGST = OFF_ZHG + 66846720;
constexpr size_t OFF_GATE = OFF_R3 + 9961472;
constexpr size_t OFF_WAUX = OFF_GATE + ARR;
constexpr size_t OFF_S5W = OFF_WAUX + 2048 * 384 * 2;
constexpr size_t OFF_WGLU = OFF_R3 + (size_t)3712 * 1024 * 2;
constexpr size_t OFF_HID = OFF_R4;
constexpr size_t WS_NEEDED = OFF_R4 + 142606336;
constexpr size_t OFF_BAR = WS_NEEDED;
static_assert(OFF_BAR + 3456 * 4 <= 268435456, "workspace");
static_assert(OFF_HGST + 26738688 <= WS_NEEDED, "ws2");
static_assert(OFF_RWP + 8 * ARR <= WS_NEEDED, "ws3");
static_assert(OFF_S5W + 393216 <= OFF_R4, "ws4");

struct P {
    const float *x, *c, *ctx, *c_ctx, *w_mod, *b_mod, *norm1_g, *w_in, *s5_lam_re, *s5_lam_im, *s5_log_step,
        *s5_b_re, *s5_b_im, *s5_c_re, *s5_c_im, *s5_d, *s5_w_glu, *s5_b_glu, *hgrn_lb, *hgrn_norm_g,
        *rwkv_mu, *rwkv_w0, *rwkv_w2, *rwkv_a0, *rwkv_a2, *rwkv_g2, *rwkv_k_k, *rwkv_k_a, *rwkv_r_k,
        *rwkv_ln_w, *rwkv_ln_b, *w_out, *norm2_g, *w_ff1, *w_ff2, *norm_f_g;
    float* out;
    unsigned char* ws;
};

DI int tidx() { int t = threadIdx.x; asm volatile("" : "+v"(t)); return t; }
DI int bidx() { int b = blockIdx.x; asm volatile("" : "+s"(b)); return b; }
DI float bf2f(bf16_t v) { return __uint_as_float(((unsigned)v) << 16); }
typedef __bf16 hwbf16x2 __attribute__((ext_vector_type(2)));
DI unsigned pack2(float lo, float hi) { const hwbf16x2 v = __builtin_convertvector((f32x2){lo, hi}, hwbf16x2); return __builtin_bit_cast(unsigned, v); }
DI bf16_t f2bf(float f) { return (bf16_t)(pack2(f, 0.f) & 0xffffu); }
DI float bflo(unsigned w) { return __uint_as_float(w << 16); }
DI float bfhi(unsigned w) { return __uint_as_float(w & 0xffff0000u); }
DI float frcp(float x) { return __builtin_amdgcn_rcpf(x); }
DI float sigm(float x) { return frcp(1.0f + __expf(-x)); }
DI float tanh_fast(float x) { return 1.0f - 2.0f * frcp(__expf(2.0f * x) + 1.0f); }
DI float wave_sum(float v) {
#pragma unroll
    for (int o = 32; o > 0; o >>= 1) v += __shfl_xor(v, o);
    return v;
}
template <int CTRL> DI float dppf(float x) { return __builtin_bit_cast(float, __builtin_amdgcn_mov_dpp(__builtin_bit_cast(int, x), CTRL, 0xf, 0xf, true)); }
DI float red16(float x) { x += dppf<0xB1>(x); x += dppf<0x4E>(x); x += dppf<0x141>(x); x += dppf<0x128>(x); return x; }
DI int rw_row(int step, int dr, int b) {
    if (dr == 0) return step < 256 ? NLAT + b * 256 + step : b * 4096 + (step - 256);
    return step < 256 ? NLAT + b * 256 + 255 - step : b * 4096 + 4095 - (step - 256);
}
DI void lds_barrier() { asm volatile("s_waitcnt lgkmcnt(0)" ::: "memory"); __builtin_amdgcn_s_barrier(); asm volatile("" ::: "memory"); }
DI int permrow(int m) { return m < NLAT ? ((m & ~4095) | ((m & 63) << 6) | ((m >> 6) & 63)) : m; }

namespace pg8 {
#define PG8_LAS __attribute__((address_space(3)))
typedef unsigned u32x4 __attribute__((ext_vector_type(4)));
constexpr int BM = 256, BK = 64, HALF = 128, HTB = HALF * BK * 2, STAGE_BYTES = 8 * HTB, NXCD = 8, WGM = 8;
DI int lds_byte(int r, int c) { const int st = (r >> 4) * 2 + (c >> 5), rr = r & 15, cc = c & 31, ob = rr * 64 + cc * 2; return st * 1024 + (ob ^ (((ob >> 9) & 1) << 5)); }
DI void stage_rc(int b, int& R, int& C) { const int st = b / 1024, sb = b % 1024, swz = sb ^ (((sb >> 9) & 1) << 5); R = (st >> 1) * 16 + swz / 64; C = (st & 1) * 32 + (swz % 64) / 2; }
struct Unit { int pm, pn; };
struct Gemm { const bf16_t* A; const bf16_t* Bt; int M, N, K; int lda, ldb, tps; };
struct StaticOrder {
    int nM, nN, nwg, G, c;
    DI void init(int M, int N, int G_, int c_) { nM = M / BM; nN = N / BM; nwg = nM * nN; G = G_; c = c_; }
    DI bool next(int i, Unit& u) const {
        const long L = (long)i * G + c; if (L >= nwg) return false;
        int wgid = (int)L; { const int q = nwg / NXCD, r = nwg % NXCD, xcd = wgid % NXCD, off = wgid / NXCD; wgid = (xcd < r ? xcd * (q + 1) : r * (q + 1) + (xcd - r) * q) + off; }
        const int nig = WGM * nN, gid = wgid / nig, fm = gid * WGM, gsz = (nM - fm) < WGM ? (nM - fm) : WGM;
        u.pm = fm + ((wgid % nig) % gsz); u.pn = (wgid % nig) / gsz; return true;
    }
};
template <class Epi>
DI void gemm_phase(PG8_LAS unsigned char* lds, const Gemm g, const StaticOrder& S, const Epi& E) {
    const int tid = tidx(), wid = __builtin_amdgcn_readfirstlane(tid >> 6), lane = tid & 63, wr = wid >> 2, wc = wid & 3, fr = lane & 15, fq = lane >> 4;
    const int K = g.K, nt = K / BK;
    unsigned voffA[2], voffB[2];
#pragma unroll
    for (int i = 0; i < 2; ++i) { int R, C; stage_rc(tid * 16 + i * 8192, R, C); voffA[i] = (unsigned)(R * g.lda + C) * 2u; voffB[i] = (unsigned)(R * g.ldb + C) * 2u; }
    const size_t kstep = (size_t)(BK * 2);
    const size_t hstepA = (size_t)HALF * g.lda * 2, hstepB = (size_t)HALF * g.ldb * 2;
    const size_t tstepA = 2 * hstepA, tstepB = 2 * hstepB;
    const int tps = g.tps;
    const size_t sstep = (size_t)K * 2;
    const unsigned ldsw = (unsigned)wid * 1024u;
    const int aoff = lds_byte(wr * 64 + fr, fq * 8), boff = lds_byte(wc * 32 + fr, fq * 8);
#define PG8_SA(b, h) (((b) * 2 + (h)) * HTB)
#define PG8_SB(b, h) ((4 + (b) * 2 + (h)) * HTB)
#define PG8_STAGE(bufoff, gbase, voff) do { _Pragma("unroll") for (int _i = 0; _i < 2; ++_i) \
        __builtin_amdgcn_global_load_lds((const unsigned*)((const char*)(gbase) + (voff)[_i]), (PG8_LAS unsigned*)(lds + (bufoff) + ldsw + _i * 8192), 16, 0, 0); } while (0)
#define PG8_LDA(dst, b, h) do { _Pragma("unroll") for (int m = 0; m < 4; ++m) _Pragma("unroll") for (int k = 0; k < 2; ++k) dst[m][k] = *(const PG8_LAS bf16x8*)(lds + PG8_SA(b, h) + aoff + m * 2048 + k * 1024); } while (0)
#define PG8_LDB(dst, b, h) do { _Pragma("unroll") for (int n = 0; n < 2; ++n) _Pragma("unroll") for (int k = 0; k < 2; ++k) dst[n][k] = *(const PG8_LAS bf16x8*)(lds + PG8_SB(b, h) + boff + n * 2048 + k * 1024); } while (0)
#define PG8_MMA(ai, bj, At, Bt) do { __builtin_amdgcn_s_setprio(1); _Pragma("unroll") for (int m = 0; m < 4; ++m) _Pragma("unroll") for (int n = 0; n < 2; ++n) _Pragma("unroll") for (int k = 0; k < 2; ++k) \
        acc[ai][bj][m][n] = __builtin_amdgcn_mfma_f32_16x16x32_bf16(Bt[n][k], At[m][k], acc[ai][bj][m][n], 0, 0, 0); __builtin_amdgcn_s_setprio(0); } while (0)
#define PG8_WAIT_V(n) asm volatile("s_waitcnt vmcnt(" #n ")" ::: "memory")
#define PG8_WAIT_L(n) asm volatile("s_waitcnt lgkmcnt(" #n ")" ::: "memory")
#define PG8_BAR __builtin_amdgcn_s_barrier()
#define PG8_SCHED __builtin_amdgcn_sched_barrier(0)
    Unit cur, nxt; int ui = 0;
    if (!S.next(0, cur)) return;
    f32x4 acc[2][2][4][2];
#pragma unroll
    for (int a = 0; a < 2; ++a)
#pragma unroll
        for (int b = 0; b < 2; ++b)
#pragma unroll
            for (int m = 0; m < 4; ++m)
#pragma unroll
                for (int n = 0; n < 2; ++n) acc[a][b][m][n] = (f32x4){0.f, 0.f, 0.f, 0.f};
    bf16x8 At[4][2], B0[2][2], B1[2][2];
    const char* cA = (const char*)g.A + (size_t)(cur.pm % tps) * tstepA + (size_t)(cur.pm / tps) * sstep; const char* cB = (const char*)g.Bt + (size_t)cur.pn * tstepB + (size_t)(cur.pm / tps) * sstep;
    PG8_STAGE(PG8_SB(0, 0), cB, voffB); PG8_STAGE(PG8_SA(0, 0), cA, voffA); PG8_STAGE(PG8_SB(0, 1), cB + hstepB, voffB); PG8_STAGE(PG8_SA(0, 1), cA + hstepA, voffA);
    if (wr == 1) PG8_BAR;
    PG8_WAIT_V(4); PG8_BAR;
    PG8_STAGE(PG8_SB(1, 0), cB + kstep, voffB); PG8_STAGE(PG8_SA(1, 0), cA + kstep, voffA); PG8_STAGE(PG8_SB(1, 1), cB + hstepB + kstep, voffB);
    PG8_WAIT_V(6); PG8_BAR;
    for (;;) {
        const bool has_next = S.next(ui + 1, nxt);
        const char* nA = has_next ? (const char*)g.A + (size_t)(nxt.pm % tps) * tstepA + (size_t)(nxt.pm / tps) * sstep : cA; const char* nB = has_next ? (const char*)g.Bt + (size_t)nxt.pn * tstepB + (size_t)(nxt.pm / tps) * sstep : cB;
        for (int t = 0; t < nt; t += 2) {
            const bool last = (t == nt - 2);
            const char* a1 = cA + (size_t)(t + 1) * kstep;
            const char* a2 = last ? nA : cA + (size_t)(t + 2) * kstep; const char* b2 = last ? nB : cB + (size_t)(t + 2) * kstep;
            const char* a3 = a2 + kstep; const char* b3 = b2 + kstep;
            PG8_LDB(B0, 0, 0); PG8_SCHED; PG8_LDA(At, 0, 0); PG8_STAGE(PG8_SA(1, 1), a1 + hstepA, voffA);
            PG8_WAIT_L(8); PG8_BAR; PG8_WAIT_L(0); PG8_MMA(0, 0, At, B0); PG8_BAR; PG8_SCHED;
            PG8_LDB(B1, 0, 1); PG8_STAGE(PG8_SB(0, 0), b2, voffB);
            PG8_BAR; PG8_WAIT_L(0); PG8_MMA(0, 1, At, B1); PG8_BAR;
            PG8_LDA(At, 0, 1); PG8_STAGE(PG8_SA(0, 0), a2, voffA);
            PG8_BAR; PG8_WAIT_L(0); PG8_MMA(1, 0, At, B0); PG8_BAR; PG8_SCHED;
            PG8_STAGE(PG8_SB(0, 1), b2 + hstepB, voffB);
            PG8_WAIT_V(6); PG8_BAR; PG8_MMA(1, 1, At, B1); PG8_BAR;
            PG8_LDB(B0, 1, 0); PG8_SCHED; PG8_LDA(At, 1, 0); PG8_STAGE(PG8_SA(0, 1), a2 + hstepA, voffA);
            PG8_WAIT_L(8); PG8_BAR; PG8_WAIT_L(0); PG8_MMA(0, 0, At, B0); PG8_BAR; PG8_SCHED;
            PG8_LDB(B1, 1, 1); PG8_STAGE(PG8_SB(1, 0), b3, voffB);
            PG8_BAR; PG8_WAIT_L(0); PG8_MMA(0, 1, At, B1); PG8_BAR;
            PG8_LDA(At, 1, 1); PG8_STAGE(PG8_SA(1, 0), a3, voffA);
            PG8_BAR; PG8_WAIT_L(0); PG8_MMA(1, 0, At, B0); PG8_BAR; PG8_SCHED;
            PG8_STAGE(PG8_SB(1, 1), b3 + hstepB, voffB);
            PG8_WAIT_V(6); PG8_BAR; PG8_MMA(1, 1, At, B1); PG8_BAR;
        }
        E(acc, cur, wr, wc, fr, fq);
        if (!has_next) break;
#pragma unroll
        for (int a = 0; a < 2; ++a)
#pragma unroll
            for (int b = 0; b < 2; ++b)
#pragma unroll
                for (int m = 0; m < 4; ++m)
#pragma unroll
                    for (int n = 0; n < 2; ++n) acc[a][b][m][n] = (f32x4){0.f, 0.f, 0.f, 0.f};
        cur = nxt; cA = nA; cB = nB; ++ui;
    }
    PG8_WAIT_V(0);
    if (wr == 0) PG8_BAR;
    PG8_BAR;
#undef PG8_SA
#undef PG8_SB
#undef PG8_STAGE
#undef PG8_LDA
#undef PG8_LDB
#undef PG8_MMA
#undef PG8_WAIT_V
#undef PG8_WAIT_L
#undef PG8_BAR
#undef PG8_SCHED
}
}

template <int MODE> struct Epi {
    bf16_t* o0; bf16_t* o1; bf16_t* o2;
    const float* xin_lat; float* xout_lat; const float* xin_ctx; float* xout_ctx; const float* gate;
    DI void operator()(const f32x4 (&acc)[2][2][4][2], const pg8::Unit& u, int wr, int wc, int fr, int fq) const {
#pragma unroll
        for (int ai = 0; ai < 2; ++ai)
#pragma unroll
            for (int m = 0; m < 4; ++m) {
                const int row = u.pm * 256 + ai * 128 + wr * 64 + m * 16 + fr;
#pragma unroll
                for (int bj = 0; bj < 2; ++bj)
#pragma unroll
                    for (int n = 0; n < 2; ++n) {
                        const int col = u.pn * 256 + bj * 128 + wc * 32 + n * 16 + 4 * fq;
                        const f32x4 v = acc[ai][bj][m][n];
                        if (MODE == 0) {
                            uint2 w; w.x = pack2(v[0], v[1]); w.y = pack2(v[2], v[3]);
                            if (col < 1536) *(uint2*)(o0 + (size_t)permrow(row) * 1536 + col) = w;
                            else *(uint2*)(o1 + (size_t)row * 256 + (col - 1536)) = w;
                        } else if (MODE == 7) {
                            uint2 w; w.x = pack2(v[0], v[1]); w.y = pack2(v[2], v[3]);
                            if (col < 1536) *(uint2*)(o0 + (size_t)permrow(row) * 1536 + col) = w;
                            else if (col < 1792) *(uint2*)(o1 + (size_t)row * 256 + (col - 1536)) = w;
                            else if (col < 3712) *(uint2*)(o2 + (size_t)row * 1920 + (col - 1792)) = w;
                        } else if (MODE == 1) {
                            if (col < 1920) { uint2 w; w.x = pack2(v[0], v[1]); w.y = pack2(v[2], v[3]); *(uint2*)(o0 + (size_t)row * 1920 + col) = w; }
                        } else if (MODE == 2) {
                            const float* xi; float* xo; int s;
                            if (row < NLAT) { xi = xin_lat + (size_t)row * 1024 + col; xo = xout_lat + (size_t)row * 1024 + col; s = row >> 12; }
                            else { xi = xin_ctx + (size_t)(row - NLAT) * 1024 + col; xo = xout_ctx + (size_t)(row - NLAT) * 1024 + col; s = 4; }
                            const f32x4 xv = *(const f32x4*)xi; const f32x4 gv = *(const f32x4*)(gate + s * 6144 + col);
                            *(f32x4*)xo = xv + gv * v;
                        } else if (MODE == 4) {
                            uint2 w; w.x = pack2(v[0], v[1]); w.y = pack2(v[2], v[3]);
                            if (col < 1536) *(uint2*)(o0 + (size_t)row * 1536 + col) = w;
                            else if (col < 1920) *(uint2*)(o1 + (size_t)row * 384 + (col - 1536)) = w;
                        } else if (MODE == 5) {
                            const uint2 gw = *(const uint2*)(o1 + (size_t)row * 256 + col);
                            const f32x4 bv = *(const f32x4*)(gate + col);
                            const float g0 = bflo(gw.x), g1 = bfhi(gw.x), g2 = bflo(gw.y), g3 = bfhi(gw.y);
                            uint2 w; w.x = pack2(g0 * sigm(v[0] + bv[0]), g1 * sigm(v[1] + bv[1])); w.y = pack2(g2 * sigm(v[2] + bv[2]), g3 * sigm(v[3] + bv[3]));
                            *(uint2*)(o0 + (size_t)row * 1024 + col) = w;
                            __builtin_amdgcn_sched_barrier(0);
                        } else if (MODE == 6) {
                            *(f32x4*)(xout_lat + (size_t)row * 1024 + col) = v;
                        } else {
                            f32x4 r;
#pragma unroll
                            for (int j = 0; j < 4; ++j) { const float t = fmaxf(v[j], 0.f); r[j] = t * t; }
                            uint2 w; w.x = pack2(r[0], r[1]); w.y = pack2(r[2], r[3]);
                            *(uint2*)(o0 + (size_t)row * 4096 + col) = w;
                        }
                    }
            }
    }
};

DI void ph_mods(const P& p, float* lds) {
    float* sc = lds;
    float* red = lds + 5120;
    float* mod = (float*)(p.ws + OFF_MOD);
    const int tid = tidx(), lane = tid & 63, kg = tid >> 6;
    for (int it = bidx(); it < 192; it += gridDim.x) {
        const int l = it / 96, n0 = (it % 96) * 64;
        __syncthreads();
        for (int i = tid; i < 5120; i += 512) { const int s = i >> 10, k = i & 1023; const float v = s < 4 ? p.c[s * 1024 + k] : p.c_ctx[k]; sc[i] = v * frcp(1.f + __expf(-v)); }
        __syncthreads();
        float a0 = 0.f, a1 = 0.f, a2 = 0.f, a3 = 0.f, a4 = 0.f;
        const float* w = p.w_mod + (size_t)l * 1024 * 6144 + n0 + lane;
        for (int k = kg * 128; k < kg * 128 + 128; ++k) {
            const float wv = w[(size_t)k * 6144];
            a0 += sc[k] * wv; a1 += sc[1024 + k] * wv; a2 += sc[2048 + k] * wv; a3 += sc[3072 + k] * wv; a4 += sc[4096 + k] * wv;
        }
        red[(kg * 5 + 0) * 64 + lane] = a0; red[(kg * 5 + 1) * 64 + lane] = a1; red[(kg * 5 + 2) * 64 + lane] = a2; red[(kg * 5 + 3) * 64 + lane] = a3; red[(kg * 5 + 4) * 64 + lane] = a4;
        __syncthreads();
        if (tid < 320) { const int s = tid >> 6; float t = 0.f;
#pragma unroll
            for (int g = 0; g < 8; ++g) t += red[(g * 5 + s) * 64 + lane];
            mod[(l * 5 + s) * 6144 + n0 + lane] = t + p.b_mod[l * 6144 + n0 + lane]; }
    }
}


DI float swapadd32(float x) {
    const unsigned u = __float_as_uint(x);
    auto r = __builtin_amdgcn_permlane32_swap(u, u, false, false);
    return __uint_as_float(r[0]) + __uint_as_float(r[1]);
}
DI void ph_rwscan2(const P& p, float* lds) {
    float* buf = lds;
    float* ybuf = lds + 24576;
    float* ydummy = lds + 25600;
    const int tid = tidx();
    for (int it = bidx(); it < 192; it += gridDim.x) {
        const int rg = it & 3, dr = (it >> 2) & 1, h = (it >> 3) % 6, b = it / 48;
        __syncthreads();
        const int lane = tid & 63, wv = tid >> 6;
        const int half = lane >> 5, rsel = (lane >> 4) & 1, kc = lane & 15;
        const int rr = 2 * wv + rsel, k0 = (half * 16 + kc) * 2;
        const unsigned char* rwp = p.ws + OFF_RWP;
        bf16_t* YD = (bf16_t*)(p.ws + OFF_R2 + (size_t)dr * ARR);
        f32x2 S = (f32x2){0.f, 0.f};
        uint4 rawA[3], rawB[3];
        auto issue = [&](int j, uint4 (&raw)[3]) {
#pragma unroll
            for (int e = 0; e < 3; ++e) {
                const int q = tid + 512 * e; const int slot = q / 48, rem = q % 48; const int a = rem >> 3, part = rem & 7;
                const int row = rw_row(32 * j + slot, dr, b);
                const unsigned char* base = a == 0 ? rwp + (size_t)(2 + dr) * ARR : a == 1 ? rwp + ARR : a == 2 ? rwp + (size_t)(6 + dr) * ARR : a == 3 ? rwp + (size_t)(4 + dr) * ARR : a == 4 ? rwp : p.ws + OFF_V;
                raw[e] = *(const uint4*)(base + ((size_t)row * 384 + h * 64 + part * 8) * 2);
            }
        };
        auto commit = [&](int bsel, const uint4 (&raw)[3]) {
#pragma unroll
            for (int e = 0; e < 3; ++e) {
                const int q = tid + 512 * e; const int slot = q / 48, rem = q % 48; const int a = rem >> 3, part = rem & 7;
                f32x4 f0 = (f32x4){bflo(raw[e].x), bfhi(raw[e].x), bflo(raw[e].y), bfhi(raw[e].y)}, f1 = (f32x4){bflo(raw[e].z), bfhi(raw[e].z), bflo(raw[e].w), bfhi(raw[e].w)};
                if (a == 0) { f0 = 1.0f - f0; f1 = 1.0f - f1; }
                float* dst = buf + bsel * 12288 + (slot * 6 + a) * 64 + part * 8;
                *(f32x4*)dst = f0; *(f32x4*)(dst + 4) = f1;
            }
        };
        auto flush = [&](int j) {
            const int slot = tid >> 4, r16 = tid & 15;
            const int row = rw_row(32 * j + slot, dr, b);
            YD[(size_t)row * 384 + h * 64 + rg * 16 + r16] = f2bf(ybuf[(j & 1) * 512 + slot * 16 + r16]);
        };
        issue(0, rawA); commit(0, rawA); issue(1, rawA);
        asm volatile("s_waitcnt lgkmcnt(0)" ::: "memory"); __builtin_amdgcn_s_barrier(); asm volatile("" ::: "memory");
        for (int j = 0; j < 136; ++j) {
            if (j + 2 < 136) issue(j + 2, rawB);
            {
                const float* bb = buf + (j & 1) * 12288; float* yb = ybuf + (j & 1) * 512;
                const float* tb0 = bb + k0;
                f32x2 w2 = *(const f32x2*)(tb0), kk2 = *(const f32x2*)(tb0 + 64), kka2 = *(const f32x2*)(tb0 + 128), kt2 = *(const f32x2*)(tb0 + 192), r2 = *(const f32x2*)(tb0 + 256);
                float vv = bb[320 + rg * 16 + rr];
                float* yw = (kc == 0 && half == 0) ? (yb + rr) : (ydummy + tid);
                float yp = 0.f;
#pragma unroll 8
                for (int i = 0; i < 32; ++i) {
                    const int in = i < 31 ? i + 1 : 31;
                    const float* tn = bb + in * 384 + k0;
                    const f32x2 nw2 = *(const f32x2*)(tn), nkk2 = *(const f32x2*)(tn + 64), nkka2 = *(const f32x2*)(tn + 128), nkt2 = *(const f32x2*)(tn + 192), nr2 = *(const f32x2*)(tn + 256);
                    const float nvv = bb[in * 384 + 320 + rg * 16 + rr];
                    const f32x2 td = S * kk2;
                    float d = td[0] + td[1];
                    const f32x2 kv = kt2 * vv;
                    d += dppf<0xB1>(d); yp += dppf<0xB1>(yp);
                    d += dppf<0x4E>(d); yp += dppf<0x4E>(yp);
                    d += dppf<0x141>(d); yp += dppf<0x141>(yp);
                    d += dppf<0x128>(d); yp += dppf<0x128>(yp);
                    d = swapadd32(d); yp = swapadd32(yp);
                    if (i > 0) yw[(i - 1) * 16] = yp;
                    const float sa = -d;
                    S = S * w2 + (kka2 * sa + kv);
                    const f32x2 ty = S * r2;
                    yp = ty[0] + ty[1];
                    w2 = nw2; kk2 = nkk2; kka2 = nkka2; kt2 = nkt2; r2 = nr2; vv = nvv;
                }
                yp = red16(yp); yp = swapadd32(yp);
                yw[31 * 16] = yp;
            }
            if (j + 1 < 136) commit((j + 1) & 1, rawA);
            if (j > 0) flush(j - 1);
#pragma unroll
            for (int e = 0; e < 3; ++e) rawA[e] = rawB[e];
            asm volatile("s_waitcnt lgkmcnt(0)" ::: "memory"); __builtin_amdgcn_s_barrier(); asm volatile("" ::: "memory");
        }
        flush(135);
    }
}

DI void s5_abar(const P& p, int l, int dr, int g, int pp, float& ar, float& ai, float& fr, float& fi) {
    const float step = expf(p.s5_log_step[(l * 2 + dr) * 16 + g]);
    const float lr = p.s5_lam_re[((l * 2 + dr) * 16 + g) * 64 + pp], lim = p.s5_lam_im[((l * 2 + dr) * 16 + g) * 64 + pp];
    const float mag = expf(lr * step);
    ar = mag * cosf(lim * step); ai = mag * sinf(lim * step);
    const float den = lr * lr + lim * lim;
    fr = ((ar - 1.0f) * lr + ai * lim) / den;
    fi = (ai * lr - (ar - 1.0f) * lim) / den;
}

DI void ph_convert(const P& p, int l, float* lds, int part) {
    const int tid = tidx();
    bf16_t* wt = (bf16_t*)(p.ws + OFF_R3);
    const int ntask0 = part == 0 ? 64 * 3712 : 64 * 4096, ntask1 = part == 0 ? 64 * 1024 : 256 * 1024;
    for (int task = bidx() * 512 + tid; task < ntask0 + ntask1; task += gridDim.x * 512) {
        const float* W; int K, N, n, kb, drow; bf16_t* Wt;
        if (task < ntask0) {
            if (part == 0) { K = 1024; N = 3712; n = task % 3712; kb = task / 3712; W = p.w_in + (size_t)l * 1024 * 3712; Wt = wt;
                drow = n < 256 ? 1536 + n : (n < 2176 ? 1792 + (n - 256) : n - 2176); }
            else { K = 1024; N = 4096; n = task & 4095; kb = task >> 12; W = p.w_ff1 + (size_t)l * 1024 * 4096; Wt = wt + 3840 * 1024 + 1024 * 1024; drow = n; }
        } else {
            const int t2 = task - ntask0;
            if (part == 0) { K = 1024; N = 1024; n = t2 & 1023; kb = t2 >> 10; W = p.w_out + (size_t)l * 1024 * 1024; Wt = wt + 3840 * 1024; drow = n; }
            else { K = 4096; N = 1024; n = t2 & 1023; kb = t2 >> 10; W = p.w_ff2 + (size_t)l * 4096 * 1024; Wt = wt + 3840 * 1024 + 1024 * 1024 + 4096 * 1024; drow = n; }
        }
        const float* src = W + (size_t)(kb * 16) * N + n;
        float v[16];
#pragma unroll
        for (int j = 0; j < 16; ++j) v[j] = __builtin_nontemporal_load(src + (size_t)j * N);
        bf16_t* dst = Wt + (size_t)drow * K + kb * 16;
        *(uint4*)dst = make_uint4(pack2(v[0], v[1]), pack2(v[2], v[3]), pack2(v[4], v[5]), pack2(v[6], v[7]));
        *(uint4*)(dst + 8) = make_uint4(pack2(v[8], v[9]), pack2(v[10], v[11]), pack2(v[12], v[13]), pack2(v[14], v[15]));
    }
    if (part == 0) {
        bf16_t* waux = (bf16_t*)(p.ws + OFF_WAUX); bf16_t* wglu = (bf16_t*)(p.ws + OFF_WGLU);
        for (int i = bidx() * 512 + tid; i < 2048 * 384 + 65536 + 65536; i += gridDim.x * 512) {
            if (i < 2048 * 384) {
                const int n = i / 384, k = i % 384; float v = 0.f;
                if (n < 768) { const int dr = n / 384, c = n % 384; if ((k >> 6) == dr) v = p.rwkv_w2[((size_t)(l * 2 + dr) * 64 + (k & 63)) * 384 + c]; }
                else if (n < 1536) { const int dr = (n - 768) / 384, c = (n - 768) % 384; if ((k >> 6) == 2 + dr) v = p.rwkv_a2[((size_t)(l * 2 + dr) * 64 + (k & 63)) * 384 + c]; }
                else if (n < 1920) { if (k >= 256) v = p.rwkv_g2[((size_t)l * 128 + (k - 256)) * 384 + (n - 1536)]; }
                waux[i] = f2bf(v);
            } else if (i < 2048 * 384 + 65536) { const int j = i - 2048 * 384; const int n = j >> 8, k = j & 255; wglu[j] = f2bf(p.s5_w_glu[((size_t)l * 256 + k) * 256 + n]); }
            else { wglu[i - 2048 * 384] = 0; }
        }
        bf16_t* s5w = (bf16_t*)(p.ws + OFF_S5W);
        for (int i = bidx() * 512 + tid; i < 32 * 4096 + 32 * 2048; i += gridDim.x * 512) {
            if (i < 32 * 4096) {
                const int dg = i >> 12, pq = (i >> 5) & 127, hq = i & 31; const int dr = dg >> 4, g = dg & 15, pp = pq & 63;
                float v = 0.f;
                if (hq < 16) { float ar, ai, fr, fi; s5_abar(p, l, dr, g, pp, ar, ai, fr, fi);
                    const size_t bi = ((size_t)((l * 2 + dr) * 16 + g) * 64 + pp) * 16 + hq; const float br = p.s5_b_re[bi], bm = p.s5_b_im[bi];
                    v = pq < 64 ? fr * br - fi * bm : fr * bm + fi * br; }
                s5w[i] = f2bf(v);
            } else {
                const int j = i - 32 * 4096; const int dg = j >> 11, hh = (j >> 7) & 15, pq = j & 127; const int dr = dg >> 4, g = dg & 15;
                const size_t ci = (size_t)((l * 2 + dr) * 16 + g) * 1024 + hh * 64 + (pq & 63);
                s5w[i] = f2bf(pq < 64 ? p.s5_c_re[ci] : -p.s5_c_im[ci]);
            }
        }
    }
}

DI void ph_norm(const P& p, int l, int which, int nrows) {
    const float* g = (which ? p.norm2_g : p.norm1_g) + l * 1024;
    const int shc = which ? 3 : 0, scc = shc + 1;
    const int tid = tidx(), lane = tid & 63;
    const float* mod = (const float*)(p.ws + OFF_MOD);
    const float* xc = (const float*)(p.ws + OFF_XC);
    bf16_t* H = (bf16_t*)(p.ws + OFF_R1);
    const bool from_inputs = (l == 0 && which == 0);
    for (int m0 = (bidx() * 8 + (tid >> 6)) * 2; m0 < nrows; m0 += gridDim.x * 16) {
        f32x4 v[2][4]; float ss[2]; int sidx[2];
#pragma unroll
        for (int u = 0; u < 2; ++u) {
            const int m = m0 + u; const float* src;
            if (m < NLAT) { src = (from_inputs ? p.x : p.out) + (size_t)m * 1024; sidx[u] = m >> 12; }
            else { src = (from_inputs ? p.ctx : xc) + (size_t)(m - NLAT) * 1024; sidx[u] = 4; }
            ss[u] = 0.f;
            const bool addA = (l == 1 && which == 0 && m >= NLAT);
            const bool addB = (l == 0 && which == 1 && m >= NLAT);
            if (addB) src = p.ctx + (size_t)(m - NLAT) * 1024;
#pragma unroll
            for (int j = 0; j < 4; ++j) { v[u][j] = *(const f32x4*)(src + j * 256 + lane * 4);
                if (addA || addB) { const int col = j * 256 + lane * 4; f32x4 acc = (f32x4){0.f, 0.f, 0.f, 0.f};
                    const int nsl = addA ? 8 : 4;
                    for (int sl = 0; sl < nsl; ++sl) acc += *(const f32x4*)((const float*)(p.ws + OFF_R2) + ((size_t)sl * 1024 + (m - NLAT)) * 1024 + col);
                    v[u][j] += *(const f32x4*)(mod + (0 * 5 + 4) * 6144 + (addA ? 5 : 2) * 1024 + col) * acc;
                    if (addB) *(f32x4*)((float*)(p.ws + OFF_XC) + (size_t)(m - NLAT) * 1024 + col) = v[u][j]; } ss[u] += v[u][j][0] * v[u][j][0] + v[u][j][1] * v[u][j][1] + v[u][j][2] * v[u][j][2] + v[u][j][3] * v[u][j][3]; }
        }
#pragma unroll
        for (int u = 0; u < 2; ++u) {
            const int m = m0 + u;
            const float rstd = rsqrtf(wave_sum(ss[u]) * (1.0f / 1024.0f) + 1e-6f);
            const float* md = mod + (l * 5 + sidx[u]) * 6144;
#pragma unroll
            for (int j = 0; j < 4; ++j) {
                const int col = j * 256 + lane * 4;
                const f32x4 g4 = *(const f32x4*)(g + col), sh4 = *(const f32x4*)(md + shc * 1024 + col), sc4 = *(const f32x4*)(md + scc * 1024 + col);
                f32x4 h;
#pragma unroll
                for (int e = 0; e < 4; ++e) h[e] = v[u][j][e] * rstd * g4[e] * (1.0f + sc4[e]) + sh4[e];
                uint2 w; w.x = pack2(h[0], h[1]); w.y = pack2(h[2], h[3]);
                *(uint2*)(H + (size_t)m * 1024 + col) = w;
            }
        }
    }
}

DI void ph_rwp1(const P& p, int l, float* lds) {
    const int tid = tidx();
    const float* mu0 = p.rwkv_mu + (size_t)l * 2 * 1536; const float* mu1 = mu0 + 1536;
    const bf16_t* ZRW = (const bf16_t*)(p.ws + OFF_R2);
    bf16_t* Vv = (bf16_t*)(p.ws + OFF_V); bf16_t* AUXA = (bf16_t*)(p.ws + OFF_AUXA);
    bf16_t* Rr = (bf16_t*)(p.ws + OFF_RWP); bf16_t* KK = (bf16_t*)(p.ws + OFF_RWP + ARR); bf16_t* KTMP = (bf16_t*)(p.ws + OFF_RWP + 4 * ARR);
    const float* k_k = p.rwkv_k_k + l * 384;
    for (int task = bidx() * 512 + tid; task < NTOK * 192; task += gridDim.x * 512) {
        const int row = task / 192, cc = task % 192; const int col = cc * 8;
        int pos, slen;
        if (row < NLAT) { pos = row & 4095; slen = 4096; } else { pos = (row - NLAT) & 255; slen = 256; }
        const bf16_t* zr = ZRW + (size_t)row * 1536 + col;
        const uint4 z0 = make_uint4(0, 0, 0, 0);
        const uint4 zc = *(const uint4*)zr; const uint4 zp = pos > 0 ? *(const uint4*)(zr - 1536) : z0; const uint4 zn = (pos + 1 < slen) ? *(const uint4*)(zr + 1536) : z0;
        const unsigned cw[4] = {zc.x, zc.y, zc.z, zc.w}, pw[4] = {zp.x, zp.y, zp.z, zp.w}, nw[4] = {zn.x, zn.y, zn.z, zn.w};
        const f32x4 m0a = *(const f32x4*)(mu0 + col), m0b = *(const f32x4*)(mu0 + col + 4), m1a = *(const f32x4*)(mu1 + col), m1b = *(const f32x4*)(mu1 + col + 4);
        float o[8];
#pragma unroll
        for (int e = 0; e < 4; ++e) {
            const float c0 = bflo(cw[e]), c1 = bfhi(cw[e]), q0 = bflo(pw[e]), q1 = bfhi(pw[e]), n0 = bflo(nw[e]), n1 = bfhi(nw[e]);
            const float ma0 = e < 2 ? m0a[2 * e] : m0b[2 * e - 4], ma1 = e < 2 ? m0a[2 * e + 1] : m0b[2 * e - 3];
            const float mb0 = e < 2 ? m1a[2 * e] : m1b[2 * e - 4], mb1 = e < 2 ? m1a[2 * e + 1] : m1b[2 * e - 3];
            o[2 * e] = c0 + ma0 * (q0 - c0) + mb0 * (n0 - c0);
            o[2 * e + 1] = c1 + ma1 * (q1 - c1) + mb1 * (n1 - c1);
        }
        const int seg = cc / 48, c = (cc % 48) * 8;
        const size_t oo = (size_t)row * 384 + c;
        const f32x4 kka = *(const f32x4*)(k_k + c), kkb = *(const f32x4*)(k_k + c + 4);
        float kq[8]; float ss = 0.f;
#pragma unroll
        for (int e = 0; e < 8; ++e) { kq[e] = o[e] * (e < 4 ? kka[e] : kkb[e - 4]); ss += kq[e] * kq[e]; }
        ss += dppf<0xB1>(ss); ss += dppf<0x4E>(ss); ss += dppf<0x141>(ss);
        const float iv = rsqrtf(fmaxf(ss, 1e-24f));
        const uint4 po = make_uint4(pack2(o[0], o[1]), pack2(o[2], o[3]), pack2(o[4], o[5]), pack2(o[6], o[7]));
        if (seg == 0) *(uint4*)(Rr + oo) = po;
        else if (seg == 1) { *(uint4*)(KTMP + oo) = po;
            *(uint4*)(KK + oo) = make_uint4(pack2(kq[0] * iv, kq[1] * iv), pack2(kq[2] * iv, kq[3] * iv), pack2(kq[4] * iv, kq[5] * iv), pack2(kq[6] * iv, kq[7] * iv)); }
        else if (seg == 2) *(uint4*)(Vv + oo) = po;
        else {
            float a[8];
#pragma unroll
            for (int e = 0; e < 8; ++e) a[e] = c < 128 ? tanh_fast(o[e]) : (c >= 256 ? sigm(o[e]) : o[e]);
            *(uint4*)(AUXA + oo) = make_uint4(pack2(a[0], a[1]), pack2(a[2], a[3]), pack2(a[4], a[5]), pack2(a[6], a[7]));
        }
    }
}
DI void ph_rwp2(const P& p, int l) {
    const int tid = tidx(), lane = tid & 63, sub = lane >> 4, l16 = lane & 15;
    const bf16_t* PRE = (const bf16_t*)(p.ws + OFF_R2);
    const bf16_t* Rr = (const bf16_t*)(p.ws + OFF_RWP); const bf16_t* KK = (const bf16_t*)(p.ws + OFF_RWP + ARR);
    bf16_t* KT0 = (bf16_t*)(p.ws + OFF_RWP + 4 * ARR);
    float* CB = (float*)(p.ws + OFF_CB);
    for (int grp = bidx() * 8 + (tid >> 6); grp < NTOK * 6 / 4; grp += gridDim.x * 8) {
        const int task = grp * 4 + sub; const int row = task / 6, h = task % 6, c = h * 64 + l16 * 4;
        const size_t o = (size_t)row * 384 + c;
        const uint2 kx = *(const uint2*)(KT0 + o), kkx = *(const uint2*)(KK + o), rx = *(const uint2*)(Rr + o);
        uint2 pw[2], pa[2];
#pragma unroll
        for (int dr = 0; dr < 2; ++dr) { pw[dr] = *(const uint2*)(PRE + (size_t)row * 1536 + dr * 384 + c); pa[dr] = *(const uint2*)(PRE + (size_t)row * 1536 + 768 + dr * 384 + c); }
        const float k4[4] = {bflo(kx.x), bfhi(kx.x), bflo(kx.y), bfhi(kx.y)}, kk4[4] = {bflo(kkx.x), bfhi(kkx.x), bflo(kkx.y), bfhi(kkx.y)}, r4[4] = {bflo(rx.x), bfhi(rx.x), bflo(rx.y), bfhi(rx.y)};
        const f32x4 ka4 = *(const f32x4*)(p.rwkv_k_a + l * 384 + c), rk4 = *(const f32x4*)(p.rwkv_r_k + l * 384 + c);
        float bsum = 0.f;
#pragma unroll
        for (int dr = 0; dr < 2; ++dr) {
            const f32x4 w04 = *(const f32x4*)(p.rwkv_w0 + (l * 2 + dr) * 384 + c), a04 = *(const f32x4*)(p.rwkv_a0 + (l * 2 + dr) * 384 + c);
            const float pw4[4] = {bflo(pw[dr].x), bfhi(pw[dr].x), bflo(pw[dr].y), bfhi(pw[dr].y)}, pa4[4] = {bflo(pa[dr].x), bfhi(pa[dr].x), bflo(pa[dr].y), bfhi(pa[dr].y)};
            float ow[4], okt[4], oka[4];
#pragma unroll
            for (int e = 0; e < 4; ++e) {
                const float ew = 0.60653066f * sigm(w04[e] + pw4[e]);
                ow[e] = 1.0f - __expf(-ew);
                const float a = sigm(a04[e] + pa4[e]);
                okt[e] = k4[e] * (1.0f + (a - 1.0f) * ka4[e]);
                oka[e] = kk4[e] * a;
                bsum += r4[e] * okt[e] * rk4[e];
            }
            uint2 t; t.x = pack2(ow[0], ow[1]); t.y = pack2(ow[2], ow[3]); *(uint2*)((bf16_t*)(p.ws + OFF_RWP + (size_t)(2 + dr) * ARR) + o) = t;
            t.x = pack2(okt[0], okt[1]); t.y = pack2(okt[2], okt[3]); *(uint2*)((bf16_t*)(p.ws + OFF_RWP + (size_t)(4 + dr) * ARR) + o) = t;
            t.x = pack2(oka[0], oka[1]); t.y = pack2(oka[2], oka[3]); *(uint2*)((bf16_t*)(p.ws + OFF_RWP + (size_t)(6 + dr) * ARR) + o) = t;
        }
        bsum = red16(bsum);
        if (l16 == 0) CB[(size_t)row * 6 + h] = bsum;
    }
}

DI void ph_rwscan(const P& p, float* lds) {
    float* buf = lds;
    float* ybuf = lds + 24576;
    float* ydummy = lds + 26624;
    const int tid = tidx();
    for (int cb = bidx(); cb < 192; cb += gridDim.x) {
        const int it = (((cb & 7) * 6 + (cb >> 5)) << 2) | ((cb >> 3) & 3);
        const int rg = it & 3, dr = (it >> 2) & 1, h = (it >> 3) % 6, b = it / 48;
        __syncthreads();
        const bool consumer = tid < 256;
        const int rr = (tid >> 4) & 15, kc = tid & 15, lt = tid & 255;
        const unsigned char* rwp = p.ws + OFF_RWP;
        bf16_t* YD = (bf16_t*)(p.ws + OFF_R2 + (size_t)dr * ARR);
        f32x2 S01 = (f32x2){0.f, 0.f}, S23 = (f32x2){0.f, 0.f};
        uint4 rawA[6], rawB[6];
        const int lslot = lt >> 3, lpart = lt & 7;
        auto issue = [&](int j, uint4 (&raw)[6]) {
            const int row = rw_row(32 * j + lslot, dr, b);
            const size_t off = ((size_t)row * 384 + h * 64 + lpart * 8) * 2;
            raw[0] = *(const uint4*)(rwp + (size_t)(2 + dr) * ARR + off);
            raw[1] = *(const uint4*)(rwp + ARR + off);
            raw[2] = *(const uint4*)(rwp + (size_t)(6 + dr) * ARR + off);
            raw[3] = *(const uint4*)(rwp + (size_t)(4 + dr) * ARR + off);
            raw[4] = *(const uint4*)(rwp + off);
            raw[5] = *(const uint4*)(p.ws + OFF_V + off);
        };
        auto commit = [&](int bsel, const uint4 (&raw)[6]) {
            float* dst = buf + bsel * 12288 + lslot * 384 + lpart * 8;
#pragma unroll
            for (int a = 0; a < 6; ++a) {
                f32x4 f0 = (f32x4){bflo(raw[a].x), bfhi(raw[a].x), bflo(raw[a].y), bfhi(raw[a].y)}, f1 = (f32x4){bflo(raw[a].z), bfhi(raw[a].z), bflo(raw[a].w), bfhi(raw[a].w)};
                if (a == 0) { f0 = 1.0f - f0; f1 = 1.0f - f1; }
                *(f32x4*)(dst + a * 64) = f0; *(f32x4*)(dst + a * 64 + 4) = f1;
            }
        };
        auto flush = [&](int j) {
#pragma unroll
            for (int e = 0; e < 2; ++e) {
                const int q = lt + 256 * e; const int slot = q >> 4, r16 = q & 15;
                const int row = rw_row(32 * j + slot, dr, b);
                const f32x2 yh = *(const f32x2*)(ybuf + (j & 1) * 1024 + (slot * 16 + r16) * 2);
                YD[(size_t)row * 384 + h * 64 + rg * 16 + r16] = f2bf(yh[0] + yh[1]);
            }
        };
        if (!consumer) { issue(0, rawA); commit(0, rawA); issue(1, rawA); }
        asm volatile("s_waitcnt lgkmcnt(0)" ::: "memory"); __builtin_amdgcn_s_barrier(); asm volatile("" ::: "memory");
        for (int j = 0; j < 136; ++j) {
            if (consumer) {
                const float* bb = buf + (j & 1) * 12288; float* yb = ybuf + (j & 1) * 1024;
                const float* tb0 = bb + kc * 4;
                f32x4 w4 = *(const f32x4*)(tb0), kk4 = *(const f32x4*)(tb0 + 64), kka4 = *(const f32x4*)(tb0 + 128), kt4 = *(const f32x4*)(tb0 + 192), r4 = *(const f32x4*)(tb0 + 256);
                float vv = bb[320 + rg * 16 + rr];
                float* yw = ((kc & 7) == 0) ? (yb + rr * 2 + (kc >> 3)) : (ydummy + tid);
                float yp = 0.f;
#pragma unroll
                for (int i = 0; i < 32; ++i) {
                    const int in = i < 31 ? i + 1 : 31;
                    const float* tn = bb + in * 384 + kc * 4;
                    const f32x4 nw4 = *(const f32x4*)(tn), nkk4 = *(const f32x4*)(tn + 64), nkka4 = *(const f32x4*)(tn + 128), nkt4 = *(const f32x4*)(tn + 192), nr4 = *(const f32x4*)(tn + 256);
                    const float nvv = bb[in * 384 + 320 + rg * 16 + rr];
                    f32x2 td = S01 * (f32x2){kk4[0], kk4[1]}; td = S23 * (f32x2){kk4[2], kk4[3]} + td;
                    float d = td[0] + td[1];
                    const f32x2 kv01 = (f32x2){kt4[0], kt4[1]} * vv, kv23 = (f32x2){kt4[2], kt4[3]} * vv;
                    d += dppf<0xB1>(d); yp += dppf<0xB1>(yp);
                    d += dppf<0x4E>(d); yp += dppf<0x4E>(yp);
                    d += dppf<0x141>(d); yp += dppf<0x141>(yp);
                    d += dppf<0x128>(d);
                    if (i > 0) yw[(i - 1) * 32] = yp;
                    const float sa = -d;
                    S01 = S01 * (f32x2){w4[0], w4[1]} + ((f32x2){kka4[0], kka4[1]} * sa + kv01);
                    S23 = S23 * (f32x2){w4[2], w4[3]} + ((f32x2){kka4[2], kka4[3]} * sa + kv23);
                    f32x2 ty = S01 * (f32x2){r4[0], r4[1]}; ty = S23 * (f32x2){r4[2], r4[3]} + ty;
                    yp = ty[0] + ty[1];
                    w4 = nw4; kk4 = nkk4; kka4 = nkka4; kt4 = nkt4; r4 = nr4; vv = nvv;
                }
                yp += dppf<0xB1>(yp); yp += dppf<0x4E>(yp); yp += dppf<0x141>(yp);
                yw[31 * 32] = yp;
            } else {
                if (j + 2 < 136) issue(j + 2, rawB);
                if (j + 1 < 136) commit((j + 1) & 1, rawA);
                if (j > 0) flush(j - 1);
#pragma unroll
                for (int e = 0; e < 6; ++e) rawA[e] = rawB[e];
            }
            asm volatile("s_waitcnt lgkmcnt(0)" ::: "memory"); __builtin_amdgcn_s_barrier(); asm volatile("" ::: "memory");
        }
        if (!consumer) flush(135);
    }
}


DI void ph_rwscan3(const P& p, float* lds) {
    float* buf = lds;
    float* ybuf = lds + 24576;
    float* ydummy = lds + 25600;
    float* abuf = lds + 26624;
    const int tid = tidx();
    for (int it = bidx(); it < 192; it += gridDim.x) {
        const int rg = it & 3, dr = (it >> 2) & 1, h = (it >> 3) % 6, b = it / 48;
        __syncthreads();
        const bool consumer = tid < 256;
        const int rr = (tid >> 4) & 15, kc = tid & 15, lt = tid & 255;
        const int lslot = lt >> 3, lpart = lt & 7;
        const unsigned char* rwp = p.ws + OFF_RWP;
        bf16_t* YD = (bf16_t*)(p.ws + OFF_R2 + (size_t)dr * ARR);
        f32x2 S01 = (f32x2){0.f, 0.f}, S23 = (f32x2){0.f, 0.f};
        float Dred = 0.f, sa_prev = 0.f, vv_prev = 0.f, a_cur = 0.f, b_cur = 0.f;
        uint4 rawA[6], rawB[6];
        auto issue = [&](int j, uint4 (&raw)[6]) {
            const int step = 32 * j + lslot;
            const int row = rw_row(step, dr, b);
            const int rown = rw_row(step < 4351 ? step + 1 : step, dr, b);
            const size_t off = ((size_t)row * 384 + h * 64 + lpart * 8) * 2, offn = ((size_t)rown * 384 + h * 64 + lpart * 8) * 2;
            raw[0] = *(const uint4*)(rwp + (size_t)(2 + dr) * ARR + off);
            raw[1] = *(const uint4*)(rwp + ARR + offn);
            raw[2] = *(const uint4*)(rwp + (size_t)(6 + dr) * ARR + off);
            raw[3] = *(const uint4*)(rwp + (size_t)(4 + dr) * ARR + off);
            raw[4] = *(const uint4*)(rwp + off);
            raw[5] = *(const uint4*)(p.ws + OFF_V + off);
        };
        auto commit = [&](int bsel, const uint4 (&raw)[6]) {
            f32x4 f[6][2];
#pragma unroll
            for (int a = 0; a < 6; ++a) { f[a][0] = (f32x4){bflo(raw[a].x), bfhi(raw[a].x), bflo(raw[a].y), bfhi(raw[a].y)}; f[a][1] = (f32x4){bflo(raw[a].z), bfhi(raw[a].z), bflo(raw[a].w), bfhi(raw[a].w)}; }
            f[0][0] = 1.0f - f[0][0]; f[0][1] = 1.0f - f[0][1];
            const f32x4 wk0 = f[0][0] * f[1][0], wk1 = f[0][1] * f[1][1];
            const f32x4 pa = f[2][0] * f[1][0] + f[2][1] * f[1][1], pb = f[3][0] * f[1][0] + f[3][1] * f[1][1];
            float an = (pa[0] + pa[1]) + (pa[2] + pa[3]), bn = (pb[0] + pb[1]) + (pb[2] + pb[3]);
            an += dppf<0xB1>(an); bn += dppf<0xB1>(bn); an += dppf<0x4E>(an); bn += dppf<0x4E>(bn); an += dppf<0x141>(an); bn += dppf<0x141>(bn);
            float* dst = buf + bsel * 12288 + lslot * 384 + lpart * 8;
            *(f32x4*)(dst) = f[0][0]; *(f32x4*)(dst + 4) = f[0][1];
            *(f32x4*)(dst + 64) = wk0; *(f32x4*)(dst + 68) = wk1;
            *(f32x4*)(dst + 128) = f[2][0]; *(f32x4*)(dst + 132) = f[2][1];
            *(f32x4*)(dst + 192) = f[3][0]; *(f32x4*)(dst + 196) = f[3][1];
            *(f32x4*)(dst + 256) = f[4][0]; *(f32x4*)(dst + 260) = f[4][1];
            *(f32x4*)(dst + 320) = f[5][0]; *(f32x4*)(dst + 324) = f[5][1];
            if (lpart == 0) { abuf[(bsel * 32 + lslot) * 2] = an; abuf[(bsel * 32 + lslot) * 2 + 1] = bn; }
        };
        auto flush = [&](int j) {
#pragma unroll
            for (int e = 0; e < 2; ++e) {
                const int q = lt + 256 * e; const int slot = q >> 4, r16 = q & 15;
                const int row = rw_row(32 * j + slot, dr, b);
                YD[(size_t)row * 384 + h * 64 + rg * 16 + r16] = f2bf(ybuf[(j & 1) * 512 + slot * 16 + r16]);
            }
        };
        if (!consumer) { issue(0, rawA); commit(0, rawA); issue(1, rawA); }
        lds_barrier();
        for (int j = 0; j < 136; ++j) {
            if (consumer) {
                const float* bb = buf + (j & 1) * 12288; float* yb = ybuf + (j & 1) * 512; const float* ab = abuf + (j & 1) * 64;
                const float* tb0 = bb + kc * 4;
                f32x4 w4 = *(const f32x4*)(tb0), wk4 = *(const f32x4*)(tb0 + 64), kka4 = *(const f32x4*)(tb0 + 128), kt4 = *(const f32x4*)(tb0 + 192), r4 = *(const f32x4*)(tb0 + 256);
                float vv = bb[320 + rg * 16 + rr];
                f32x2 abn = *(const f32x2*)ab;
                float* yw = (kc == 0) ? (yb + rr) : (ydummy + tid);
                float yp = 0.f;
#pragma unroll 8
                for (int i = 0; i < 32; ++i) {
                    const int in = i < 31 ? i + 1 : 31;
                    const float* tn = bb + in * 384 + kc * 4;
                    const f32x4 nw4 = *(const f32x4*)(tn), nwk4 = *(const f32x4*)(tn + 64), nkka4 = *(const f32x4*)(tn + 128), nkt4 = *(const f32x4*)(tn + 192), nr4 = *(const f32x4*)(tn + 256);
                    const float nvv = bb[in * 384 + 320 + rg * 16 + rr];
                    const f32x2 nabn = *(const f32x2*)(ab + in * 2);
                    const float d = Dred + sa_prev * a_cur + vv_prev * b_cur;
                    const float sa = -d;
                    f32x2 tp = S01 * (f32x2){wk4[0], wk4[1]}; tp = S23 * (f32x2){wk4[2], wk4[3]} + tp;
                    float pn = tp[0] + tp[1];
                    const f32x2 kv01 = (f32x2){kt4[0], kt4[1]} * vv, kv23 = (f32x2){kt4[2], kt4[3]} * vv;
                    S01 = S01 * (f32x2){w4[0], w4[1]} + ((f32x2){kka4[0], kka4[1]} * sa + kv01);
                    S23 = S23 * (f32x2){w4[2], w4[3]} + ((f32x2){kka4[2], kka4[3]} * sa + kv23);
                    pn += dppf<0xB1>(pn); yp += dppf<0xB1>(yp);
                    pn += dppf<0x4E>(pn); yp += dppf<0x4E>(yp);
                    pn += dppf<0x141>(pn); yp += dppf<0x141>(yp);
                    pn += dppf<0x128>(pn); yp += dppf<0x128>(yp);
                    if (i > 0) yw[(i - 1) * 16] = yp;
                    f32x2 ty = S01 * (f32x2){r4[0], r4[1]}; ty = S23 * (f32x2){r4[2], r4[3]} + ty;
                    yp = ty[0] + ty[1];
                    Dred = pn; sa_prev = sa; vv_prev = vv; a_cur = abn[0]; b_cur = abn[1];
                    w4 = nw4; wk4 = nwk4; kka4 = nkka4; kt4 = nkt4; r4 = nr4; vv = nvv; abn = nabn;
                }
                yp = red16(yp);
                yw[31 * 16] = yp;
            } else {
                if (j + 2 < 136) issue(j + 2, rawB);
                if (j + 1 < 136) commit((j + 1) & 1, rawA);
                if (j > 0) flush(j - 1);
#pragma unroll
                for (int e = 0; e < 6; ++e) rawA[e] = rawB[e];
            }
            lds_barrier();
        }
        if (!consumer) flush(135);
    }
}

template <bool RO> DI void ph_s5(const P& p, int l, float* lds, int bstart, int bstride) {
    const int tid = tidx(), lane = tid & 63, wv = tid >> 6, fr = lane & 15, fq = lane >> 4;
    float* BU = lds + wv * 2048;
    bf16_t* Hb = (bf16_t*)(lds + 8 * 2048) + wv * (16 * 136);
    float* ysum = lds + 8 * 2048 + 8 * 16 * 136 / 2;
    const bf16_t* ZS5 = (const bf16_t*)(p.ws + OFF_ZS5);
    bf16_t* G5 = (bf16_t*)(p.ws + OFF_G5);
    float2* ST = (float2*)(p.ws + OFF_S5ST);
    const bf16_t* s5w = (const bf16_t*)(p.ws + OFF_S5W);
    int cur_gq = -1;
    float ar = 0.f, ai = 0.f, fr_ = 0.f, fi_ = 0.f;
    bf16x8 bfrag[8]; bf16x8 cfrag[4];
    for (int it = bstart; it < 1088; it += bstride) {
        const int gq = it & 3; const int rem = it >> 2; const int cidx = rem % 68, b = rem / 68;
        const int gl_ = wv & 3, dr = wv >> 2, g = gq * 4 + gl_, dg = dr * 16 + g;
        const int row0 = cidx < 4 ? NLAT + b * 256 + cidx * 64 : b * 4096 + (cidx - 4) * 64;
        lds_barrier();
        if (RO) {
#pragma unroll
            for (int i = 0; i < 8; ++i) ysum[tid + 512 * i] = 0.f;
        }
        if (gq != cur_gq) {
            cur_gq = gq;
            s5_abar(p, l, dr, g, lane, ar, ai, fr_, fi_);
#pragma unroll
            for (int nt = 0; nt < 8; ++nt) bfrag[nt] = *(const bf16x8*)(s5w + (size_t)dg * 4096 + (16 * nt + fr) * 32 + 8 * fq);
            if (RO) {
#pragma unroll
                for (int ks = 0; ks < 4; ++ks) cfrag[ks] = *(const bf16x8*)(s5w + 32 * 4096 + (size_t)dg * 2048 + fr * 128 + 32 * ks + 8 * fq);
            }
        }
        float hr = 0.f, hi = 0.f;
        const size_t sidx = ((size_t)((b * 2 + dr) * 68 + cidx) * 16 + g) * 64 + lane;
        if (RO) { const float2 s0 = ST[sidx]; hr = s0.x; hi = s0.y; }
        lds_barrier();
        bf16x8 afr[4];
#pragma unroll
        for (int sb = 0; sb < 4; ++sb) {
            const int s_a = 16 * sb + fr; const int t_a = dr ? 63 - s_a : s_a;
            afr[sb] = (bf16x8){0, 0, 0, 0, 0, 0, 0, 0};
            if (fq < 2) afr[sb] = *(const bf16x8*)(ZS5 + (size_t)(row0 + t_a) * 256 + g * 16 + 8 * fq);
        }
#pragma unroll
        for (int sb = 0; sb < 4; ++sb) {
            const bf16x8 afrag = afr[sb];
#pragma unroll
            for (int nt = 0; nt < 8; ++nt) {
                f32x4 acc = __builtin_amdgcn_mfma_f32_16x16x32_bf16(afrag, bfrag[nt], (f32x4){0.f, 0.f, 0.f, 0.f}, 0, 0, 0);
#pragma unroll
                for (int r = 0; r < 4; ++r) BU[(fq * 4 + r) * 128 + 16 * nt + fr] = acc[r];
            }
            asm volatile("s_waitcnt lgkmcnt(0)" ::: "memory");
            float burv[16], buiv[16];
#pragma unroll
            for (int sl = 0; sl < 16; ++sl) { burv[sl] = BU[sl * 128 + lane]; buiv[sl] = BU[sl * 128 + 64 + lane]; }
#pragma unroll
            for (int sl = 0; sl < 16; ++sl) {
                const float bur = burv[sl], bui = buiv[sl];
                const float nhr = ar * hr - ai * hi + bur, nhi = ar * hi + ai * hr + bui;
                hr = nhr; hi = nhi;
                if (RO) { Hb[sl * 136 + lane] = f2bf(hr); Hb[sl * 136 + 64 + lane] = f2bf(hi); }
            }
            if (RO) {
                asm volatile("s_waitcnt lgkmcnt(0)" ::: "memory");
                f32x4 acc = (f32x4){0.f, 0.f, 0.f, 0.f};
#pragma unroll
                for (int ks = 0; ks < 4; ++ks) acc = __builtin_amdgcn_mfma_f32_16x16x32_bf16(*(const bf16x8*)(Hb + fr * 136 + 32 * ks + 8 * fq), cfrag[ks], acc, 0, 0, 0);
#pragma unroll
                for (int r = 0; r < 4; ++r) { const int s2 = 16 * sb + fq * 4 + r; const int t2 = dr ? 63 - s2 : s2; atomicAdd(&ysum[t2 * 64 + gl_ * 16 + fr], acc[r]); }
                asm volatile("s_waitcnt lgkmcnt(0)" ::: "memory");
            }
        }
        if (!RO) { ST[sidx] = make_float2(hr, hi); }
        else {
            lds_barrier();
            const float* dd = p.s5_d + l * 256 + gq * 64;
#pragma unroll
            for (int i = 0; i < 8; ++i) { const int idx = tid + 512 * i; const int t = idx >> 6, ch = idx & 63;
                const float u = bf2f(ZS5[(size_t)(row0 + t) * 256 + gq * 64 + ch]);
                const float xv = ysum[idx] + dd[ch] * u;
                const float ge = 0.5f * xv * (1.0f + tanh_fast(0.7978845608f * (xv + 0.044715f * xv * xv * xv)));
                G5[(size_t)(row0 + t) * 256 + gq * 64 + ch] = f2bf(ge); }
        }
    }
}

DI void ph_s5carry(const P& p, int l, int bstart, int bstride) {
    float2* ST = (float2*)(p.ws + OFF_S5ST);
    for (int i = bstart * 512 + tidx(); i < 8192; i += bstride * 512) {
        const int pp = i & 63, g = (i >> 6) & 15, dr = (i >> 10) & 1, b = i >> 11;
        float ar, ai, fr, fi; s5_abar(p, l, dr, g, pp, ar, ai, fr, fi);
#pragma unroll
        for (int q = 0; q < 6; ++q) { const float nr = ar * ar - ai * ai, ni = 2.0f * ar * ai; ar = nr; ai = ni; }
        float sr = 0.f, si = 0.f;
        for (int k0 = 0; k0 < 68; k0 += 17) {
            float2 Eb[17];
#pragma unroll
            for (int q = 0; q < 17; ++q) { const int k = k0 + q; const int c = dr == 0 ? k : (k < 4 ? 3 - k : 71 - k); Eb[q] = ST[((size_t)((b * 2 + dr) * 68 + c) * 16 + g) * 64 + pp]; }
#pragma unroll
            for (int q = 0; q < 17; ++q) { const int k = k0 + q; const int c = dr == 0 ? k : (k < 4 ? 3 - k : 71 - k);
                ST[((size_t)((b * 2 + dr) * 68 + c) * 16 + g) * 64 + pp] = make_float2(sr, si);
                const float nr = ar * sr - ai * si + Eb[q].x, ni = ar * si + ai * sr + Eb[q].y; sr = nr; si = ni; }
        }
    }
}

DI float hg_lb(const P& p, int l, int dr, int c) {
    if (l == 0) return 0.f;
    const float e0 = __expf(p.hgrn_lb[(0 * 2 + dr) * 384 + c]), e1 = __expf(p.hgrn_lb[(1 * 2 + dr) * 384 + c]);
    return e1 / (e0 + e1);
}
DI void hg_prep(const P& p, int l, int dr, int h, int row_base, int sb, float* pb) {
    const int tid = tidx(); const int st = tid >> 4, c4 = (tid & 15) * 4;
    const int s = 32 * sb + st; const int tl = dr ? 127 - s : s;
    const bf16_t* z = (const bf16_t*)(p.ws + OFF_ZHG) + (size_t)(row_base + tl) * 1920 + h * 64 + c4;
    const uint2 zq = *(const uint2*)z, zi = *(const uint2*)(z + 384), zf = *(const uint2*)(z + 768 + dr * 384);
    const float qv[4] = {bflo(zq.x), bfhi(zq.x), bflo(zq.y), bfhi(zq.y)}, iv[4] = {bflo(zi.x), bfhi(zi.x), bflo(zi.y), bfhi(zi.y)}, fv[4] = {bflo(zf.x), bfhi(zf.x), bflo(zf.y), bfhi(zf.y)};
    f32x4 fo, ko, vo, qo;
#pragma unroll
    for (int e = 0; e < 4; ++e) {
        const float lb = hg_lb(p, l, dr, h * 64 + c4 + e);
        const float ex = __expf(-fv[e]);
        const float sg = 1.0f / (1.0f + ex);
        const float sgn = 1.0f / (1.0f + __expf(fv[e]));
        fo[e] = lb + (1.0f - lb) * sg; ko[e] = (1.0f - lb) * sgn; vo[e] = iv[e]; qo[e] = qv[e] * sigm(qv[e]);
    }
    float* d = pb + st * 256 + c4;
    *(f32x4*)d = fo; *(f32x4*)(d + 64) = ko; *(f32x4*)(d + 128) = vo; *(f32x4*)(d + 192) = qo;
}
DI void ph_hg1(const P& p, int l, float* lds) {
    float* pb = lds;
    const int tid = tidx(), lane = tid & 63, wv = tid >> 6, jj = lane & 7, ig = lane >> 3;
    float* HGST = (float*)(p.ws + OFF_HGST); float* HGF = (float*)(p.ws + OFF_HGF);
    for (int it = bidx(); it < 1632; it += gridDim.x) {
        const int cidx = it % 34; const int rest = it / 34; const int dr = rest & 1, h = (rest >> 1) % 6, b = rest / 12;
        const int row_base = cidx < 2 ? NLAT + b * 256 + cidx * 128 : b * 4096 + (cidx - 2) * 128;
        float S[8], Fp[8];
#pragma unroll
        for (int e = 0; e < 8; ++e) { S[e] = 0.f; Fp[e] = 1.f; }
        for (int sb = 0; sb < 4; ++sb) {
            __syncthreads();
            hg_prep(p, l, dr, h, row_base, sb, pb);
            __syncthreads();
#pragma unroll 4
            for (int st = 0; st < 32; ++st) {
                const float* q = pb + st * 256;
                const f32x4 f0 = *(const f32x4*)(q + ig * 8), f1 = *(const f32x4*)(q + ig * 8 + 4), k0 = *(const f32x4*)(q + 64 + ig * 8), k1 = *(const f32x4*)(q + 64 + ig * 8 + 4);
                const float vj = q[128 + wv * 8 + jj];
#pragma unroll
                for (int e = 0; e < 4; ++e) { S[e] = f0[e] * S[e] + k0[e] * vj; S[4 + e] = f1[e] * S[4 + e] + k1[e] * vj; Fp[e] *= f0[e]; Fp[4 + e] *= f1[e]; }
            }
        }
        const size_t sbase = (size_t)(((b * 6 + h) * 2 + dr) * 34 + cidx);
#pragma unroll
        for (int e = 0; e < 8; ++e) HGST[sbase * 4096 + (ig * 8 + e) * 64 + wv * 8 + jj] = S[e];
        if (wv == 0 && jj == 0) {
#pragma unroll
            for (int e = 0; e < 8; ++e) HGF[sbase * 64 + ig * 8 + e] = Fp[e];
        }
    }
}
DI void ph_hgcarry(const P& p) {
    float* HGST = (float*)(p.ws + OFF_HGST); const float* HGF = (const float*)(p.ws + OFF_HGF);
    for (int idx = bidx() * 512 + tidx(); idx < 196608; idx += gridDim.x * 512) {
        const int j = idx & 63, i = (idx >> 6) & 63, seq = idx >> 12; const int dr = seq & 1;
        float S = 0.f;
        for (int k0 = 0; k0 < 34; k0 += 17) {
            float Eb[17], Fb[17];
#pragma unroll
            for (int q = 0; q < 17; ++q) { const int k = k0 + q; const int c = dr == 0 ? k : (k < 2 ? 1 - k : 35 - k);
                Eb[q] = HGST[(size_t)(seq * 34 + c) * 4096 + i * 64 + j]; Fb[q] = HGF[(size_t)(seq * 34 + c) * 64 + i]; }
#pragma unroll
            for (int q = 0; q < 17; ++q) { const int k = k0 + q; const int c = dr == 0 ? k : (k < 2 ? 1 - k : 35 - k);
                HGST[(size_t)(seq * 34 + c) * 4096 + i * 64 + j] = S; S = Fb[q] * S + Eb[q]; }
        }
    }
}
DI void ph_hg3(const P& p, int l, float* lds, bool skip_ctx) {
    float* pb = lds; float* osum = lds + 8192;
    const int tid = tidx(), lane = tid & 63, wv = tid >> 6, jj = lane & 7, ig = lane >> 3;
    const float* HGST = (const float*)(p.ws + OFF_HGST);
    bf16_t* Y = (bf16_t*)(p.ws + OFF_R1);
    const bf16_t* ZHG = (const bf16_t*)(p.ws + OFF_ZHG);
    for (int it = bidx(); it < 816; it += gridDim.x) {
        const int cidx = it % 34, h = (it / 34) % 6, b = it / 204;
        if (skip_ctx && cidx < 2) continue;
        const int row_base = cidx < 2 ? NLAT + b * 256 + cidx * 128 : b * 4096 + (cidx - 2) * 128;
        for (int dr = 0; dr < 2; ++dr) {
            const size_t sbase = (size_t)(((b * 6 + h) * 2 + dr) * 34 + cidx);
            float S[8];
#pragma unroll
            for (int e = 0; e < 8; ++e) S[e] = HGST[sbase * 4096 + (ig * 8 + e) * 64 + wv * 8 + jj];
            for (int sb = 0; sb < 4; ++sb) {
                __syncthreads();
                hg_prep(p, l, dr, h, row_base, sb, pb);
                __syncthreads();
                const float* qp = pb + ig * 8;
                f32x4 f0 = *(const f32x4*)(qp), f1 = *(const f32x4*)(qp + 4), k0 = *(const f32x4*)(qp + 64), k1 = *(const f32x4*)(qp + 68), q0 = *(const f32x4*)(qp + 192), q1 = *(const f32x4*)(qp + 196);
                float vj = pb[128 + wv * 8 + jj];
#pragma unroll 4
                for (int st = 0; st < 32; ++st) {
                    const int sn = st < 31 ? st + 1 : 31;
                    const float* qn = pb + sn * 256 + ig * 8;
                    const f32x4 nf0 = *(const f32x4*)(qn), nf1 = *(const f32x4*)(qn + 4), nk0 = *(const f32x4*)(qn + 64), nk1 = *(const f32x4*)(qn + 68), nq0 = *(const f32x4*)(qn + 192), nq1 = *(const f32x4*)(qn + 196);
                    const float nvj = pb[sn * 256 + 128 + wv * 8 + jj];
                    float o = 0.f;
#pragma unroll
                    for (int e = 0; e < 4; ++e) { S[e] = f0[e] * S[e] + k0[e] * vj; S[4 + e] = f1[e] * S[4 + e] + k1[e] * vj; o += q0[e] * S[e] + q1[e] * S[4 + e]; }
                    f0 = nf0; f1 = nf1; k0 = nk0; k1 = nk1; q0 = nq0; q1 = nq1; vj = nvj;
                    o += dppf<0x128>(o);
                    o += __shfl_xor(o, 16);
                    o += __shfl_xor(o, 32);
                    const int s = 32 * sb + st; const int tl = dr ? 127 - s : s;
                    if (lane < 8) { float* op = osum + tl * 64 + wv * 8 + jj; if (dr == 0) *op = o; else *op += o; }
                }
            }
        }
        __syncthreads();
        { const int t = tid >> 2, qd = tid & 3;
          const float* op = osum + t * 64 + qd * 16;
          float ov[16]; float ss = 0.f;
#pragma unroll
          for (int q = 0; q < 4; ++q) { const f32x4 o4 = *(const f32x4*)(op + q * 4);
#pragma unroll
              for (int e = 0; e < 4; ++e) { ov[q * 4 + e] = o4[e]; ss += o4[e] * o4[e]; } }
          ss += dppf<0xB1>(ss); ss += dppf<0x4E>(ss);
          const float rs = rsqrtf(ss * (1.0f / 64.0f) + 1e-6f);
          const int row = row_base + t; const int c0 = h * 64 + qd * 16;
          const bf16_t* gz = ZHG + (size_t)row * 1920 + 1536 + c0;
          const uint4 g0 = *(const uint4*)gz, g1 = *(const uint4*)(gz + 8);
          const unsigned gw[8] = {g0.x, g0.y, g0.z, g0.w, g1.x, g1.y, g1.z, g1.w};
          const float* ng = p.hgrn_norm_g + l * 384 + c0;
          unsigned ow[8];
#pragma unroll
          for (int e = 0; e < 8; ++e) {
              const float ga = bflo(gw[e]), gb = bfhi(gw[e]);
              const float oa = ov[2 * e] * rs * ng[2 * e] * (ga * sigm(ga)), ob = ov[2 * e + 1] * rs * ng[2 * e + 1] * (gb * sigm(gb));
              ow[e] = pack2(oa, ob);
          }
          bf16_t* yo = Y + (size_t)row * 1024 + 256 + c0;
          *(uint4*)yo = make_uint4(ow[0], ow[1], ow[2], ow[3]); *(uint4*)(yo + 8) = make_uint4(ow[4], ow[5], ow[6], ow[7]); }
    }
}


constexpr int HS = 72;
constexpr size_t OFF_HGF2 = OFF_HGST + 26738688;
static_assert(OFF_HGF2 + 835584 <= OFF_RWP + 8 * ARR, "ws5");
DI bf16x8 ldfrag(const bf16_t* p) { return *(const bf16x8*)p; }
DI int hgm_rowbase(int cidx, int b) { return cidx < 4 ? NLAT + b * 256 + cidx * 64 : b * 4096 + (cidx - 4) * 64; }

DI void ph_hg1m(const P& p, int l, float* lds) {
    bf16_t* kT = (bf16_t*)lds;
    bf16_t* vT = kT + 64 * HS;
    float* tot = (float*)(vT + 64 * HS);
    const int tid = tidx(), lane = tid & 63, wv = tid >> 6, fr = lane & 15, fq = lane >> 4;
    const int i = lane, o = wv;
    const bf16_t* ZHG = (const bf16_t*)(p.ws + OFF_ZHG);
    bf16_t* ET = (bf16_t*)(p.ws + OFF_HGST); float* HGF = (float*)(p.ws + OFF_HGF2);
    bf16_t* stg = (bf16_t*)(tot + 512);
    const int ls = tid >> 3, lc8 = (tid & 7) * 8;
    uint4 rF, rV, nF, nV;
    auto fetch1 = [&](int it, uint4& xf, uint4& xv) {
        const int cidx = it % 68; const int rest = it / 68; const int dr = rest & 1, h = (rest >> 1) % 6, b = rest / 12;
        const int tl = dr ? 63 - ls : ls;
        const bf16_t* z = ZHG + (size_t)(hgm_rowbase(cidx, b) + tl) * 1920 + h * 64 + lc8;
        xf = *(const uint4*)(z + 768 + dr * 384); xv = *(const uint4*)(z + 384);
    };
    if (bidx() < 3264) fetch1(bidx(), rF, rV);
    for (int it = bidx(); it < 3264; it += gridDim.x) {
        const int cidx = it % 68; const int rest = it / 68; const int dr = rest & 1, h = (rest >> 1) % 6, b = rest / 12;
        const size_t sbase = (size_t)(((b * 6 + h) * 2 + dr) * 68 + cidx);
        const float lb = hg_lb(p, l, dr, h * 64 + i);
        *(uint4*)(stg + ls * 64 + lc8) = rF; *(uint4*)(stg + 4096 + ls * 64 + lc8) = rV;
        if (it + (int)gridDim.x < 3264) fetch1(it + gridDim.x, nF, nV);
        lds_barrier();
        float kv[8], vv[8], G[8];
        float run = 0.f;
#pragma unroll
        for (int e = 0; e < 8; ++e) {
            const float fz = bf2f(stg[(8 * o + e) * 64 + i]); vv[e] = bf2f(stg[4096 + (8 * o + e) * 64 + i]);
            const float sg = frcp(1.0f + __expf(-fz)), sgn = frcp(1.0f + __expf(fz));
            const float f = lb + (1.0f - lb) * sg;
            kv[e] = (1.0f - lb) * sgn;
            run += __logf(f); G[e] = run;
        }
        tot[o * 64 + i] = run;
        lds_barrier();
        float off = 0.f, glast = 0.f;
#pragma unroll
        for (int q = 0; q < 8; ++q) { const float t = tot[q * 64 + i]; if (q < o) off += t; glast += t; }
        unsigned kw[4], vw[4];
#pragma unroll
        for (int e = 0; e < 4; ++e) {
            const float k0 = kv[2 * e] * __expf(glast - (off + G[2 * e])), k1 = kv[2 * e + 1] * __expf(glast - (off + G[2 * e + 1]));
            kw[e] = pack2(k0, k1); vw[e] = pack2(vv[2 * e], vv[2 * e + 1]);
        }
        *(uint4*)(kT + i * HS + 8 * o) = make_uint4(kw[0], kw[1], kw[2], kw[3]);
        *(uint4*)(vT + i * HS + 8 * o) = make_uint4(vw[0], vw[1], vw[2], vw[3]);
        if (o == 0) HGF[sbase * 64 + i] = __expf(glast);
        lds_barrier();
#pragma unroll
        for (int q2 = 0; q2 < 2; ++q2) {
            const int tile = wv * 2 + q2; const int it_ = tile >> 2, jt = tile & 3;
            f32x4 acc = (f32x4){0.f, 0.f, 0.f, 0.f};
#pragma unroll
            for (int ks = 0; ks < 2; ++ks)
                acc = __builtin_amdgcn_mfma_f32_16x16x32_bf16(ldfrag(kT + (16 * it_ + fr) * HS + 32 * ks + 8 * fq), ldfrag(vT + (16 * jt + fr) * HS + 32 * ks + 8 * fq), acc, 0, 0, 0);
            uint2 w; w.x = pack2(acc[0], acc[1]); w.y = pack2(acc[2], acc[3]);
            *(uint2*)(ET + sbase * 4096 + (16 * jt + fr) * 64 + 16 * it_ + fq * 4) = w;
        }
        rF = nF; rV = nV;
    }
}
DI void ph_hgcarrym(const P& p) {
    bf16_t* ST = (bf16_t*)(p.ws + OFF_HGST); const float* HGF = (const float*)(p.ws + OFF_HGF2);
    for (int idx = bidx() * 512 + tidx(); idx < 49152; idx += gridDim.x * 512) {
        const int i4 = (idx & 15) * 4, j = (idx >> 4) & 63, seq = idx >> 10; const int dr = seq & 1;
        f32x4 S = (f32x4){0.f, 0.f, 0.f, 0.f};
        for (int k0 = 0; k0 < 68; k0 += 17) {
            uint2 Eb[17]; f32x4 Fb[17];
#pragma unroll
            for (int q = 0; q < 17; ++q) { const int k = k0 + q; const int c = dr == 0 ? k : (k < 4 ? 3 - k : 71 - k);
                Eb[q] = *(const uint2*)(ST + (size_t)(seq * 68 + c) * 4096 + j * 64 + i4); Fb[q] = *(const f32x4*)(HGF + (size_t)(seq * 68 + c) * 64 + i4); }
#pragma unroll
            for (int q = 0; q < 17; ++q) { const int k = k0 + q; const int c = dr == 0 ? k : (k < 4 ? 3 - k : 71 - k);
                uint2 o; o.x = pack2(S[0], S[1]); o.y = pack2(S[2], S[3]);
                *(uint2*)(ST + (size_t)(seq * 68 + c) * 4096 + j * 64 + i4) = o;
                const f32x4 E = (f32x4){bflo(Eb[q].x), bfhi(Eb[q].x), bflo(Eb[q].y), bfhi(Eb[q].y)};
                S = Fb[q] * S + E; }
        }
    }
}
DI void ph_hg3m(const P& p, int l, float* lds, bool skip_ctx) {
    bf16_t* qP = (bf16_t*)lds;
    bf16_t* qI = qP + 64 * HS;
    bf16_t* kD = qI + 64 * HS;
    bf16_t* kR = kD + 64 * HS;
    bf16_t* vT = kR + 96 * HS;
    bf16_t* aS = vT + 64 * HS;
    float* tot = (float*)(aS + 64 * HS);
    float* osum = tot + 512;
    const int tid = tidx(), lane = tid & 63, wv = tid >> 6, fr = lane & 15, fq = lane >> 4;
    const int i = lane, o = wv, I = wv >> 1;
    const bf16_t* ZHG = (const bf16_t*)(p.ws + OFF_ZHG);
    const bf16_t* ST = (const bf16_t*)(p.ws + OFF_HGST);
    bf16_t* Y = (bf16_t*)(p.ws + OFF_R1);
    const int nitems = skip_ctx ? 1536 : 1632;
    auto decode = [&](int idx, int& cidx, int& h, int& b) {
        if (skip_ctx) { cidx = 4 + (idx & 63); h = (idx >> 6) % 6; b = idx / 384; } else { cidx = idx % 68; h = (idx / 68) % 6; b = idx / 408; }
    };
    bf16_t* stg = (bf16_t*)(osum + 4096);
    const int ls = tid >> 3, lc8 = (tid & 7) * 8;
    uint4 rQ, rF, rV, nQ, nF, nV;
    auto fetch3 = [&](int idx, int dr, uint4& xq, uint4& xf, uint4& xv) {
        int cidx, h, b; decode(idx, cidx, h, b);
        const int tl = dr ? 63 - ls : ls;
        const bf16_t* z = ZHG + (size_t)(hgm_rowbase(cidx, b) + tl) * 1920 + h * 64 + lc8;
        xq = *(const uint4*)z; xf = *(const uint4*)(z + 768 + dr * 384); xv = *(const uint4*)(z + 384);
    };
    if (bidx() < nitems) fetch3(bidx(), 0, rQ, rF, rV);
    for (int it = bidx(); it < nitems; it += gridDim.x) {
        int cidx, h, b; decode(it, cidx, h, b);
        const int row_base = hgm_rowbase(cidx, b);
        lds_barrier();
        for (int q = tid; q < 64 * HS / 2; q += 512) ((unsigned*)aS)[q] = 0u;
        for (int dr = 0; dr < 2; ++dr) {
            const size_t sbase = (size_t)(((b * 6 + h) * 2 + dr) * 68 + cidx);
            const float lb = hg_lb(p, l, dr, h * 64 + i);
            *(uint4*)(stg + ls * 64 + lc8) = rQ; *(uint4*)(stg + 4096 + ls * 64 + lc8) = rF; *(uint4*)(stg + 8192 + ls * 64 + lc8) = rV;
            if (dr == 0) fetch3(it, 1, nQ, nF, nV);
            else if (it + (int)gridDim.x < nitems) fetch3(it + gridDim.x, 0, nQ, nF, nV);
            bf16x8 sfr[2][2];
#pragma unroll
            for (int q2 = 0; q2 < 2; ++q2)
#pragma unroll
                for (int ks = 0; ks < 2; ++ks) sfr[q2][ks] = ldfrag(ST + sbase * 4096 + (16 * ((wv & 1) * 2 + q2) + fr) * 64 + 8 * fq + 32 * ks);
            lds_barrier();
            float kv[8], vv[8], qv[8], G[8];
            float run = 0.f;
#pragma unroll
            for (int e = 0; e < 8; ++e) {
                const int so = (8 * o + e) * 64 + i;
                const float qz = bf2f(stg[so]); const float fz = bf2f(stg[4096 + so]); vv[e] = bf2f(stg[8192 + so]);
                const float sg = frcp(1.0f + __expf(-fz)), sgn = frcp(1.0f + __expf(fz));
                const float f = lb + (1.0f - lb) * sg;
                kv[e] = (1.0f - lb) * sgn; qv[e] = qz * sigm(qz);
                run += __logf(f); G[e] = run;
            }
            tot[o * 64 + i] = run;
            lds_barrier();
            float gb[5]; gb[0] = 0.f;
            float off = 0.f;
#pragma unroll
            for (int q = 0; q < 8; ++q) { const float t = tot[q * 64 + i]; if (q < o) off += t; if (q & 1) gb[(q >> 1) + 1] = 0.f; }
            { float acc2 = 0.f;
#pragma unroll
              for (int q = 0; q < 8; ++q) { acc2 += tot[q * 64 + i]; if (q & 1) gb[(q >> 1) + 1] = acc2; } }
            const float gbI = I == 0 ? gb[0] : I == 1 ? gb[1] : I == 2 ? gb[2] : gb[3];
            const float egb = __expf(gbI);
            unsigned vw[4];
#pragma unroll
            for (int e = 0; e < 8; ++e) {
                const int s = 8 * o + e;
                const float Gs = off + G[e];
                const float ef = __expf(Gs - gbI);
                qI[s * HS + i] = f2bf(qv[e] * ef);
                qP[s * HS + i] = f2bf(qv[e] * ef * egb);
                kD[s * HS + i] = f2bf(kv[e] * frcp(fmaxf(ef, 1e-35f)));
                if (I < 1) kR[(0 + s) * HS + i] = f2bf(kv[e] * __expf(gb[1] - Gs));
                if (I < 2) kR[(16 + s) * HS + i] = f2bf(kv[e] * __expf(gb[2] - Gs));
                if (I < 3) kR[(48 + s) * HS + i] = f2bf(kv[e] * __expf(gb[3] - Gs));
            }
#pragma unroll
            for (int e = 0; e < 4; ++e) vw[e] = pack2(vv[2 * e], vv[2 * e + 1]);
            *(uint4*)(vT + i * HS + 8 * o) = make_uint4(vw[0], vw[1], vw[2], vw[3]);
            lds_barrier();
            for (int tt = wv; tt < 10; tt += 8) {
                const int TI = tt < 1 ? 0 : tt < 3 ? 1 : tt < 6 ? 2 : 3; const int TJ = tt - (TI * (TI + 1)) / 2;
                const int kbase = TI == 1 ? 0 : TI == 2 ? 16 : 48;
                const bf16_t* ap = qI + (16 * TI + fr) * HS + 8 * fq;
                const bf16_t* bp = (TJ == TI) ? kD + (16 * TI + fr) * HS + 8 * fq : kR + (kbase + 16 * TJ + fr) * HS + 8 * fq;
                f32x4 acc = (f32x4){0.f, 0.f, 0.f, 0.f};
#pragma unroll
                for (int ks = 0; ks < 2; ++ks) acc = __builtin_amdgcn_mfma_f32_16x16x32_bf16(ldfrag(ap + 32 * ks), ldfrag(bp + 32 * ks), acc, 0, 0, 0);
#pragma unroll
                for (int r = 0; r < 4; ++r) { const int sl = fq * 4 + r; const float val = (TJ == TI && fr > sl) ? 0.f : acc[r]; aS[(16 * TI + sl) * HS + 16 * TJ + fr] = f2bf(val); }
            }
            lds_barrier();
#pragma unroll
            for (int q2 = 0; q2 < 2; ++q2) {
                const int jt = (wv & 1) * 2 + q2;
                f32x4 acc = (f32x4){0.f, 0.f, 0.f, 0.f};
                const bf16_t* a1 = qP + (16 * I + fr) * HS + 8 * fq;
                const bf16_t* a2 = aS + (16 * I + fr) * HS + 8 * fq; const bf16_t* b2 = vT + (16 * jt + fr) * HS + 8 * fq;
#pragma unroll
                for (int ks = 0; ks < 2; ++ks) acc = __builtin_amdgcn_mfma_f32_16x16x32_bf16(ldfrag(a1 + 32 * ks), sfr[q2][ks], acc, 0, 0, 0);
#pragma unroll
                for (int ks = 0; ks < 2; ++ks) acc = __builtin_amdgcn_mfma_f32_16x16x32_bf16(ldfrag(a2 + 32 * ks), ldfrag(b2 + 32 * ks), acc, 0, 0, 0);
#pragma unroll
                for (int r = 0; r < 4; ++r) { const int s = 16 * I + fq * 4 + r; const int tl = dr ? 63 - s : s; float* op = osum + tl * 64 + 16 * jt + fr; if (dr == 0) *op = acc[r]; else *op += acc[r]; }
            }
            rQ = nQ; rF = nF; rV = nV;
        }
        lds_barrier();
        { const int t = tid >> 3, oc = tid & 7;
          const float* op = osum + t * 64 + oc * 8;
          const f32x4 o0 = *(const f32x4*)op, o1 = *(const f32x4*)(op + 4);
          float ss = o0[0] * o0[0] + o0[1] * o0[1] + o0[2] * o0[2] + o0[3] * o0[3] + o1[0] * o1[0] + o1[1] * o1[1] + o1[2] * o1[2] + o1[3] * o1[3];
          ss += dppf<0xB1>(ss); ss += dppf<0x4E>(ss); ss += dppf<0x141>(ss);
          const float rs = rsqrtf(ss * (1.0f / 64.0f) + 1e-6f);
          const int row = row_base + t; const int c0 = h * 64 + oc * 8;
          const uint4 g0 = *(const uint4*)(ZHG + (size_t)row * 1920 + 1536 + c0);
          const unsigned gw[4] = {g0.x, g0.y, g0.z, g0.w};
          const float* ng = p.hgrn_norm_g + l * 384 + c0;
          const float ov[8] = {o0[0], o0[1], o0[2], o0[3], o1[0], o1[1], o1[2], o1[3]};
          unsigned ow[4];
#pragma unroll
          for (int e = 0; e < 4; ++e) {
              const float ga = bflo(gw[e]), gbv = bfhi(gw[e]);
              ow[e] = pack2(ov[2 * e] * rs * ng[2 * e] * (ga * sigm(ga)), ov[2 * e + 1] * rs * ng[2 * e + 1] * (gbv * sigm(gbv)));
          }
          *(uint4*)(Y + (size_t)row * 1024 + 256 + c0) = make_uint4(ow[0], ow[1], ow[2], ow[3]); }
    }
}

DI void ph_rwread(const P& p, int l, int nrows) {
    const int tid = tidx(), lane = tid & 63, sub = lane >> 4, l16 = lane & 15;
    const bf16_t* GATE = (const bf16_t*)(p.ws + OFF_GATE); const bf16_t* Vv = (const bf16_t*)(p.ws + OFF_V);
    const bf16_t* YF = (const bf16_t*)(p.ws + OFF_R2); const bf16_t* YB = (const bf16_t*)(p.ws + OFF_R2 + ARR);
    const float* CB = (const float*)(p.ws + OFF_CB);
    bf16_t* Y = (bf16_t*)(p.ws + OFF_R1);
    const int ngrp = nrows * 6 / 4, nw = gridDim.x * 8;
    for (int grp0 = bidx() * 8 + (tid >> 6); grp0 < ngrp; grp0 += 2 * nw) {
        uint2 yf[2], yb[2], vx[2], gx[2]; float cb[2]; int srs[2], cs[2]; bool ok[2];
#pragma unroll
        for (int u = 0; u < 2; ++u) {
            const int grp = grp0 + u * nw; ok[u] = grp < ngrp;
            const int task = (ok[u] ? grp : grp0) * 4 + sub; const int sr = task / 6, h = task % 6, c = h * 64 + l16 * 4;
            srs[u] = sr; cs[u] = c;
            const size_t o = (size_t)sr * 384 + c;
            yf[u] = *(const uint2*)(YF + o); yb[u] = *(const uint2*)(YB + o); vx[u] = *(const uint2*)(Vv + o); gx[u] = *(const uint2*)(GATE + o);
            cb[u] = CB[(size_t)sr * 6 + h];
        }
#pragma unroll
        for (int u = 0; u < 2; ++u) {
            const int sr = srs[u], c = cs[u];
            const f32x4 lw = *(const f32x4*)(p.rwkv_ln_w + l * 384 + c), lb4 = *(const f32x4*)(p.rwkv_ln_b + l * 384 + c);
            const float y4[4] = {bflo(yf[u].x) + bflo(yb[u].x), bfhi(yf[u].x) + bfhi(yb[u].x), bflo(yf[u].y) + bflo(yb[u].y), bfhi(yf[u].y) + bfhi(yb[u].y)};
            const float v4[4] = {bflo(vx[u].x), bfhi(vx[u].x), bflo(vx[u].y), bfhi(vx[u].y)}, g4[4] = {bflo(gx[u].x), bfhi(gx[u].x), bflo(gx[u].y), bfhi(gx[u].y)};
            const float mean = red16((y4[0] + y4[1]) + (y4[2] + y4[3])) * (1.0f / 64.0f);
            float d4[4], vs = 0.f;
#pragma unroll
            for (int e = 0; e < 4; ++e) { d4[e] = y4[e] - mean; vs += d4[e] * d4[e]; }
            const float rstd = rsqrtf(red16(vs) * (1.0f / 64.0f) + 64e-5f);
            float o4[4];
#pragma unroll
            for (int e = 0; e < 4; ++e) o4[e] = (d4[e] * rstd * lw[e] + lb4[e] + cb[u] * v4[e]) * g4[e];
            uint2 t; t.x = pack2(o4[0], o4[1]); t.y = pack2(o4[2], o4[3]);
            if (ok[u]) *(uint2*)(Y + (size_t)permrow(sr) * 1024 + 640 + c) = t;
        }
    }
}

DI void ph_final(const P& p) {
    const int tid = tidx(), lane = tid & 63;
    for (int m = bidx() * 8 + (tid >> 6); m < NLAT; m += gridDim.x * 8) {
        float* src = p.out + (size_t)m * 1024;
        f32x4 v[4]; float ss = 0.f;
#pragma unroll
        for (int j = 0; j < 4; ++j) { v[j] = __builtin_nontemporal_load((const f32x4*)(src + j * 256 + lane * 4)); ss += v[j][0] * v[j][0] + v[j][1] * v[j][1] + v[j][2] * v[j][2] + v[j][3] * v[j][3]; }
        ss = wave_sum(ss);
        const float rstd = rsqrtf(ss * (1.0f / 1024.0f) + 1e-6f);
#pragma unroll
        for (int j = 0; j < 4; ++j) { const int col = j * 256 + lane * 4; const f32x4 g4 = *(const f32x4*)(p.norm_f_g + col); __builtin_nontemporal_store(v[j] * rstd * g4, (f32x4*)(src + col)); }
    }
}


#define XB_TMO      128
#define XB_XCNT(j)  (256  + 64 * (j))
#define XB_XSUB(j)  (1280 + 64 * (j))
#define XB_XGEN(j)  (2304 + 64 * (j))
#define XB_TOP      3328
#define XB_TOPGEN   3392
#define XCD_BAR_WORDS 3456
#define XB_SPIN_CAP (1u << 18)
#define LAS __attribute__((address_space(3)))
DI unsigned xb_ld(unsigned* p)              { return __hip_atomic_load(p, __ATOMIC_RELAXED, __HIP_MEMORY_SCOPE_AGENT); }
DI unsigned xb_add(unsigned* p, unsigned v) { return __hip_atomic_fetch_add(p, v, __ATOMIC_RELAXED, __HIP_MEMORY_SCOPE_AGENT); }
DI unsigned xb_xcc_id() { return (unsigned)__builtin_amdgcn_s_getreg((3 << 11) | 20) & 0xFu; }
#define XB_SPIN(cond, bar) do { unsigned _sp = 0; while (cond) { __builtin_amdgcn_s_sleep(1); \
    if ((++_sp & 255u) == 0u) { if (xb_ld(&(bar)[XB_TMO])) break; if (_sp > XB_SPIN_CAP) { atomicAdd(&(bar)[XB_TMO], 1u); break; } } } } while (0)
struct XcdBarrier { unsigned* bar; unsigned x; volatile LAS unsigned* st; };
DI XcdBarrier xcd_barrier_post(unsigned* bar, volatile LAS unsigned* st) {
    XcdBarrier b; b.bar = bar; b.x = xb_xcc_id(); b.st = st;
    if (threadIdx.x == 0) (void)xb_add(&bar[XB_XCNT(b.x)], 1u);
    return b;
}
DI void xcd_barrier_complete(unsigned* bar, unsigned x, unsigned& nloc, unsigned& nx) {
    const unsigned G = gridDim.x * gridDim.y * gridDim.z;
    unsigned sum, cnt, mine, sp = 0u;
    for (;;) {
        sum = 0u; cnt = 0u; mine = 0u;
#pragma unroll
        for (unsigned j = 0; j < 16; ++j) { const unsigned c = xb_ld(&bar[XB_XCNT(j)]); sum += c; cnt += (c > 0u) ? 1u : 0u; mine = (j == x) ? c : mine; }
        if (sum == G) break;
        __builtin_amdgcn_s_sleep(1);
        if ((++sp & 255u) == 0u) { if (xb_ld(&bar[XB_TMO])) break; if (sp > XB_SPIN_CAP) { atomicAdd(&bar[XB_TMO], 1u); break; } }
    }
    nloc = mine > 0u ? mine : 1u; nx = cnt > 0u ? cnt : 1u;
}
DI void xcd_barrier(const XcdBarrier& b) {
    asm volatile("s_waitcnt vmcnt(0)" ::: "memory");
    __syncthreads();
    if (threadIdx.x == 0) {
        unsigned* bar = b.bar;
        __builtin_amdgcn_s_waitcnt(0);
        unsigned nloc = b.st[0], nx = b.st[1];
        if (nloc == 0u) { xcd_barrier_complete(bar, b.x, nloc, nx); b.st[0] = nloc; b.st[1] = nx; }
        const unsigned old = xb_add(&bar[XB_XSUB(b.x)], 1u);
        const unsigned gen = old / nloc;
        if (old + 1u == (gen + 1u) * nloc) {
            __builtin_amdgcn_fence(__ATOMIC_RELEASE, "agent");
            asm volatile("s_waitcnt vmcnt(0)" ::: "memory");
            const unsigned og = xb_add(&bar[XB_TOP], 1u);
            const unsigned tg = og / nx;
            if (og + 1u == (tg + 1u) * nx) xb_add(&bar[XB_TOPGEN], 1u);
            else XB_SPIN(xb_ld(&bar[XB_TOPGEN]) == tg, bar);
            __builtin_amdgcn_fence(__ATOMIC_ACQUIRE, "agent");
            xb_add(&bar[XB_XGEN(b.x)], 1u);
            asm volatile("s_waitcnt vmcnt(0)" ::: "memory");
        } else {
            XB_SPIN(xb_ld(&bar[XB_XGEN(b.x)]) == gen, bar);
            __builtin_amdgcn_fence(__ATOMIC_ACQUIRE, "agent");
            asm volatile("s_waitcnt vmcnt(0)" ::: "memory");
        }
    }
    __syncthreads();
}

DI void sub_barrier(unsigned* ctr, unsigned target) {
    asm volatile("s_waitcnt vmcnt(0)" ::: "memory");
    __syncthreads();
    if (threadIdx.x == 0) {
        __builtin_amdgcn_fence(__ATOMIC_RELEASE, "agent");
        asm volatile("s_waitcnt vmcnt(0)" ::: "memory");
        (void)xb_add(ctr, 1u);
        unsigned sp = 0;
        while (xb_ld(ctr) < target) { __builtin_amdgcn_s_sleep(2); if (++sp > (1u << 22)) break; }
        __builtin_amdgcn_fence(__ATOMIC_ACQUIRE, "agent");
        asm volatile("s_waitcnt vmcnt(0)" ::: "memory");
    }
    __syncthreads();
}


#if defined(__HIP_DEVICE_COMPILE__)
DI P ldp() { unsigned long long k = (unsigned long long)__builtin_amdgcn_kernarg_segment_ptr(); asm volatile("" : "+s"(k)); return *(const __attribute__((address_space(4))) P*)k; }
#else
__device__ P ldp();
#endif
template <int MODE> DI void run_gemm(PG8_LAS unsigned char* lds, const bf16_t* A, const bf16_t* Bt, int M, int N, int K, const Epi<MODE>& E, int gsz = -1, int gidx = -1) {
    asm volatile("" : "+s"(M), "+s"(N), "+s"(K));
    pg8::StaticOrder S; S.init(M, N, gsz < 0 ? (int)gridDim.x : gsz, gidx < 0 ? (int)bidx() : gidx);
    pg8::Gemm g; g.A = A; g.Bt = Bt; g.M = M; g.N = N; g.K = K; g.lda = K; g.ldb = K; g.tps = 1 << 20;
    pg8::gemm_phase(lds, g, S, E);
}

template <int MODE> DI void run_gemm_split(PG8_LAS unsigned char* lds, const bf16_t* A, const bf16_t* Bt, int rows_real, int N, int K, int nslice, int ld, const Epi<MODE>& E) {
    int M = rows_real * nslice;
    asm volatile("" : "+s"(M), "+s"(N), "+s"(K), "+s"(ld));
    pg8::StaticOrder S; S.init(M, N, (int)gridDim.x, (int)bidx());
    pg8::Gemm g; g.A = A; g.Bt = Bt; g.M = M; g.N = N; g.K = K; g.lda = ld; g.ldb = ld; g.tps = rows_real / 256;
    pg8::gemm_phase(lds, g, S, E);
}

__global__ void __launch_bounds__(512, 2) mega(P p_unused) {
    extern __shared__ __attribute__((aligned(16))) unsigned char shm[];
    cg::grid_group grid = cg::this_grid();
    __shared__ uint4 xb_words;
    if (threadIdx.x == 0) xb_words = make_uint4(0u, 0u, 0u, 0u);
    __syncthreads();
    const XcdBarrier xb = xcd_barrier_post((unsigned*)(ldp().ws + OFF_BAR), (volatile LAS unsigned*)&xb_words);
    float* lds = (float*)shm;
    PG8_LAS unsigned char* lds3 = (PG8_LAS unsigned char*)shm;
#define H ((const bf16_t*)(ldp().ws + OFF_R1))
#define WT ((const bf16_t*)(ldp().ws + OFF_R3))
#define WT_OUT (WT + 3840 * 1024)
#define WT_FF1 (WT + 3840 * 1024 + 1024 * 1024)
#define WT_FF2 (WT + 3840 * 1024 + 1024 * 1024 + 4096 * 1024)
#define xc ((float*)(ldp().ws + OFF_XC))
#define mod ((const float*)(ldp().ws + OFF_MOD))

    REP(512) { ph_mods(ldp(), lds);
    ph_convert(ldp(), 0, lds, 0); }
    grid.sync();
    for (int l = 0; l < 2; ++l) {
        const int mrows = l == 0 ? NTOK : NLAT;
        if (l == 1) ph_convert(ldp(), 1, lds, 0);
        ph_norm(ldp(), l, 0, NTOK);
        xcd_barrier(xb);
        { Epi<7> E{}; E.o0 = (bf16_t*)(ldp().ws + OFF_R2); E.o1 = (bf16_t*)(ldp().ws + OFF_ZS5); E.o2 = (bf16_t*)(ldp().ws + OFF_ZHG); run_gemm<7>(lds3, H, WT, NTOK, 3840, 1024, E); }
        xcd_barrier(xb);
        ph_hg1m(ldp(), l, lds);
        xcd_barrier(xb);
        ph_hgcarrym(ldp());
        ph_s5<false>(ldp(), l, lds, bidx(), gridDim.x);
        xcd_barrier(xb);
        ph_hg3m(ldp(), l, lds, l == 1);
        if (gridDim.x >= 32) { if (bidx() >= (int)gridDim.x - 16) ph_s5carry(ldp(), l, bidx() - ((int)gridDim.x - 16), 16); }
        else ph_s5carry(ldp(), l, bidx(), gridDim.x);
        xcd_barrier(xb);
        ph_rwp1(ldp(), l, lds);
        xcd_barrier(xb);
        { Epi<4> E{}; E.o0 = (bf16_t*)(ldp().ws + OFF_R2); E.o1 = (bf16_t*)(ldp().ws + OFF_GATE); run_gemm<4>(lds3, (const bf16_t*)(ldp().ws + OFF_AUXA), (const bf16_t*)(ldp().ws + OFF_WAUX), NTOK, 2048, 384, E); }
        xcd_barrier(xb);
        ph_rwp2(ldp(), l);
        xcd_barrier(xb);
        ph_rwscan(ldp(), lds);
        const bool s5_in_c = gridDim.x > 192;
        if (s5_in_c) {
            if (bidx() >= 192) {
                const int hb = bidx() - 192, nh = gridDim.x - 192;
                unsigned* ctr = (unsigned*)(ldp().ws + OFF_BAR);
                ph_s5<true>(ldp(), l, lds, hb, nh);
                sub_barrier(ctr, (unsigned)((l + 1) * nh));
                { Epi<5> E{}; E.o0 = (bf16_t*)(ldp().ws + OFF_R1); E.o1 = (bf16_t*)(ldp().ws + OFF_G5); E.gate = ldp().s5_b_glu + l * 256; run_gemm<5>(lds3, (const bf16_t*)(ldp().ws + OFF_G5), (const bf16_t*)(ldp().ws + OFF_WGLU), mrows, 256, 256, E, nh, hb); }
            }
        } else ph_s5<true>(ldp(), l, lds, bidx(), gridDim.x);
        xcd_barrier(xb);
        ph_rwread(ldp(), l, l == 0 ? NTOK : NLAT);
        if (!s5_in_c) { Epi<5> E{}; E.o0 = (bf16_t*)(ldp().ws + OFF_R1); E.o1 = (bf16_t*)(ldp().ws + OFF_G5); E.gate = ldp().s5_b_glu + l * 256; run_gemm<5>(lds3, (const bf16_t*)(ldp().ws + OFF_G5), (const bf16_t*)(ldp().ws + OFF_WGLU), mrows, 256, 256, E); }
        xcd_barrier(xb);
        ph_convert(ldp(), l, lds, 1);
        if (l == 0) { Epi<6> E{}; E.xout_lat = (float*)(ldp().ws + OFF_R2);
          run_gemm_split<6>(lds3, H + (size_t)NLAT * 1024, WT_OUT, 1024, 1024, 256, 4, 1024, E); }
        { Epi<2> E{}; E.xin_lat = l == 0 ? ldp().x : ldp().out; E.xout_lat = ldp().out; E.xin_ctx = l == 0 ? ldp().ctx : xc; E.xout_ctx = xc; E.gate = mod + (size_t)l * 5 * 6144 + 2 * 1024;
          run_gemm<2>(lds3, H, WT_OUT, NLAT, 1024, 1024, E); }
        xcd_barrier(xb);
        REP(64) ph_norm(ldp(), l, 1, mrows);
        xcd_barrier(xb);
        REP(2048) if (PHM & 2048) { Epi<3> E{}; E.o0 = (bf16_t*)(ldp().ws + OFF_HID); run_gemm<3>(lds3, H, WT_FF1, mrows, 4096, 1024, E); }
        xcd_barrier(xb);
        if (l == 0) { Epi<6> E{}; E.xout_lat = (float*)(ldp().ws + OFF_R2);
          run_gemm_split<6>(lds3, (const bf16_t*)(ldp().ws + OFF_HID) + (size_t)NLAT * 4096, WT_FF2, 1024, 1024, 512, 8, 4096, E); }
        { Epi<2> E{}; E.xin_lat = ldp().out; E.xout_lat = ldp().out; E.xin_ctx = xc; E.xout_ctx = xc; E.gate = mod + (size_t)l * 5 * 6144 + 5 * 1024;
          run_gemm<2>(lds3, (const bf16_t*)(ldp().ws + OFF_HID), WT_FF2, NLAT, 1024, 4096, E); }
        xcd_barrier(xb);
    }
    ph_final(ldp());
#undef H
#undef WT
#undef WT_OUT
#undef WT_FF1
#undef WT_FF2
#undef xc
#undef mod
}

extern "C" void kernel_launch(void* const* d_in, const int* in_sizes, int n_in, void* d_out, int out_size, void* d_ws, size_t ws_size, hipStream_t stream) {
    P p{};
    const float** f = (const float**)&p;
    for (int i = 0; i < 36; ++i) f[i] = (const float*)d_in[i];
    p.out = (float*)d_out; p.ws = (unsigned char*)d_ws;
    static int grid_blocks = 0;
    if (!grid_blocks) {
        int dev = 0, cus = 0, per_cu = 0;
        hipGetDevice(&dev);
        hipDeviceGetAttribute(&cus, hipDeviceAttributeMultiprocessorCount, dev);
        hipFuncSetAttribute((const void*)mega, hipFuncAttributeMaxDynamicSharedMemorySize, LDS_BYTES);
        hipOccupancyMaxActiveBlocksPerMultiprocessor(&per_cu, mega, 512, LDS_BYTES);
        if (per_cu < 1) per_cu = 1;
        grid_blocks = cus * per_cu;
        if (grid_blocks > 256) grid_blocks = 256;
    }
    if (ws_size < OFF_BAR + 3456 * 4) fprintf(stderr, "workspace too small: %zu < %zu\n", ws_size, (size_t)WS_NEEDED);
    hipMemsetAsync((unsigned char*)d_ws + OFF_BAR, 0, 3456 * 4, stream);
    void* args[] = {&p};
    hipError_t e = hipLaunchCooperativeKernel((void*)mega, dim3(grid_blocks), dim3(512), args, LDS_BYTES, stream);
    if (e != hipSuccess) fprintf(stderr, "cooperative launch failed: %s (grid %d)\n", hipGetErrorString(e), grid_blocks);
}
```

```cpp
#include <hip/hip_runtime.h>
#include <hip/hip_cooperative_groups.h>
#include <stdio.h>
namespace cg = cooperative_groups;

#define DI __device__ __forceinline__
typedef unsigned short bf16_t;
typedef float f32x4 __attribute__((ext_vector_type(4)));
typedef float f32x2 __attribute__((ext_vector_type(2)));
typedef short bf16x8 __attribute__((ext_vector_type(8)));

constexpr int NTOK = 17408, NLAT = 16384;
constexpr int LDS_BYTES = 131072;
#ifndef PHM
#define PHM 0xFFFF
#endif
#ifndef REPM
#define REPM 0
#endif
#define REP(bit) for (int _r = 0; _r < ((REPM & (bit)) ? 2 : 1); ++_r)

constexpr size_t OFF_XC = 0;
constexpr size_t OFF_MOD = 4194304;
constexpr size_t OFF_CB = OFF_MOD + 245760;
constexpr size_t OFF_S5ST = OFF_CB + 417792;
constexpr size_t OFF_HGF = OFF_S5ST + 4456448;
constexpr size_t OFF_R1 = OFF_HGF + 417792;
constexpr size_t OFF_R2 = OFF_R1 + 35651584;
constexpr size_t OFF_R3 = OFF_R2 + 53477376;
constexpr size_t OFF_R4 = OFF_R3 + 26738688;
constexpr size_t ARR = 13369344;
constexpr size_t OFF_V = OFF_R4;
constexpr size_t OFF_ZS5 = OFF_V + ARR;
constexpr size_t OFF_AUXA = OFF_ZS5 + 8912896;
constexpr size_t OFF_G5 = OFF_AUXA + 4456448;
constexpr size_t OFF_RWP = OFF_G5 + 8912896;
constexpr size_t OFF_ZHG = OFF_RWP;
constexpr size_t OFF_HGST = OFF_ZHG + 66846720;
constexpr size_t OFF_GATE = OFF_R3 + 9961472;
constexpr size_t OFF_WAUX = OFF_GATE + ARR;
constexpr size_t OFF_S5W = OFF_WAUX + 2048 * 384 * 2;
constexpr size_t OFF_WGLU = OFF_R3 + (size_t)3712 * 1024 * 2;
constexpr size_t OFF_HID = OFF_R4;
constexpr size_t WS_NEEDED = OFF_R4 + 142606336;
constexpr size_t OFF_BAR = WS_NEEDED;
static_assert(OFF_BAR + 3456 * 4 <= 268435456, "workspace");
static_assert(OFF_HGST + 26738688 <= WS_NEEDED, "ws2");
static_assert(OFF_RWP + 8 * ARR <= WS_NEEDED, "ws3");
static_assert(OFF_S5W + 393216 <= OFF_R4, "ws4");

struct P {
    const float *x, *c, *ctx, *c_ctx, *w_mod, *b_mod, *norm1_g, *w_in, *s5_lam_re, *s5_lam_im, *s5_log_step,
        *s5_b_re, *s5_b_im, *s5_c_re, *s5_c_im, *s5_d, *s5_w_glu, *s5_b_glu, *hgrn_lb, *hgrn_norm_g,
        *rwkv_mu, *rwkv_w0, *rwkv_w2, *rwkv_a0, *rwkv_a2, *rwkv_g2, *rwkv_k_k, *rwkv_k_a, *rwkv_r_k,
        *rwkv_ln_w, *rwkv_ln_b, *w_out, *norm2_g, *w_ff1, *w_ff2, *norm_f_g;
    float* out;
    unsigned char* ws;
};

DI int tidx() { int t = threadIdx.x; asm volatile("" : "+v"(t)); return t; }
DI int bidx() { int b = blockIdx.x; asm volatile("" : "+s"(b)); return b; }
DI float bf2f(bf16_t v) { return __uint_as_float(((unsigned)v) << 16); }
typedef __bf16 hwbf16x2 __attribute__((ext_vector_type(2)));
DI unsigned pack2(float lo, float hi) { const hwbf16x2 v = __builtin_convertvector((f32x2){lo, hi}, hwbf16x2); return __builtin_bit_cast(unsigned, v); }
DI bf16_t f2bf(float f) { return (bf16_t)(pack2(f, 0.f) & 0xffffu); }
DI float bflo(unsigned w) { return __uint_as_float(w << 16); }
DI float bfhi(unsigned w) { return __uint_as_float(w & 0xffff0000u); }
DI float frcp(float x) { return __builtin_amdgcn_rcpf(x); }
DI float sigm(float x) { return frcp(1.0f + __expf(-x)); }
DI float tanh_fast(float x) { return 1.0f - 2.0f * frcp(__expf(2.0f * x) + 1.0f); }
DI float wave_sum(float v) {
#pragma unroll
    for (int o = 32; o > 0; o >>= 1) v += __shfl_xor(v, o);
    return v;
}
template <int CTRL> DI float dppf(float x) { return __builtin_bit_cast(float, __builtin_amdgcn_mov_dpp(__builtin_bit_cast(int, x), CTRL, 0xf, 0xf, true)); }
DI float red16(float x) { x += dppf<0xB1>(x); x += dppf<0x4E>(x); x += dppf<0x141>(x); x += dppf<0x128>(x); return x; }
DI int rw_row(int step, int dr, int b) {
    if (dr == 0) return step < 256 ? NLAT + b * 256 + step : b * 4096 + (step - 256);
    return step < 256 ? NLAT + b * 256 + 255 - step : b * 4096 + 4095 - (step - 256);
}
DI void lds_barrier() { asm volatile("s_waitcnt lgkmcnt(0)" ::: "memory"); __builtin_amdgcn_s_barrier(); asm volatile("" ::: "memory"); }
DI int permrow(int m) { return m < NLAT ? ((m & ~4095) | ((m & 63) << 6) | ((m >> 6) & 63)) : m; }

namespace pg8 {
#define PG8_LAS __attribute__((address_space(3)))
typedef unsigned u32x4 __attribute__((ext_vector_type(4)));
constexpr int BM = 256, BK = 64, HALF = 128, HTB = HALF * BK * 2, STAGE_BYTES = 8 * HTB, NXCD = 8, WGM = 8;
DI int lds_byte(int r, int c) { const int st = (r >> 4) * 2 + (c >> 5), rr = r & 15, cc = c & 31, ob = rr * 64 + cc * 2; return st * 1024 + (ob ^ (((ob >> 9) & 1) << 5)); }
DI void stage_rc(int b, int& R, int& C) { const int st = b / 1024, sb = b % 1024, swz = sb ^ (((sb >> 9) & 1) << 5); R = (st >> 1) * 16 + swz / 64; C = (st & 1) * 32 + (swz % 64) / 2; }
struct Unit { int pm, pn; };
struct Gemm { const bf16_t* A; const bf16_t* Bt; int M, N, K; int lda, ldb, tps; };
struct StaticOrder {
    int nM, nN, nwg, G, c;
    DI void init(int M, int N, int G_, int c_) { nM = M / BM; nN = N / BM; nwg = nM * nN; G = G_; c = c_; }
    DI bool next(int i, Unit& u) const {
        const long L = (long)i * G + c; if (L >= nwg) return false;
        int wgid = (int)L; { const int q = nwg / NXCD, r = nwg % NXCD, xcd = wgid % NXCD, off = wgid / NXCD; wgid = (xcd < r ? xcd * (q + 1) : r * (q + 1) + (xcd - r) * q) + off; }
        const int nig = WGM * nN, gid = wgid / nig, fm = gid * WGM, gsz = (nM - fm) < WGM ? (nM - fm) : WGM;
        u.pm = fm + ((wgid % nig) % gsz); u.pn = (wgid % nig) / gsz; return true;
    }
};
template <class Epi>
DI void gemm_phase(PG8_LAS unsigned char* lds, const Gemm g, const StaticOrder& S, const Epi& E) {
    const int tid = tidx(), wid = __builtin_amdgcn_readfirstlane(tid >> 6), lane = tid & 63, wr = wid >> 2, wc = wid & 3, fr = lane & 15, fq = lane >> 4;
    const int K = g.K, nt = K / BK;
    unsigned voffA[2], voffB[2];
#pragma unroll
    for (int i = 0; i < 2; ++i) { int R, C; stage_rc(tid * 16 + i * 8192, R, C); voffA[i] = (unsigned)(R * g.lda + C) * 2u; voffB[i] = (unsigned)(R * g.ldb + C) * 2u; }
    const size_t kstep = (size_t)(BK * 2);
    const size_t hstepA = (size_t)HALF * g.lda * 2, hstepB = (size_t)HALF * g.ldb * 2;
    const size_t tstepA = 2 * hstepA, tstepB = 2 * hstepB;
    const int tps = g.tps;
    const size_t sstep = (size_t)K * 2;
    const unsigned ldsw = (unsigned)wid * 1024u;
    const int aoff = lds_byte(wr * 64 + fr, fq * 8), boff = lds_byte(wc * 32 + fr, fq * 8);
#define PG8_SA(b, h) (((b) * 2 + (h)) * HTB)
#define PG8_SB(b, h) ((4 + (b) * 2 + (h)) * HTB)
#define PG8_STAGE(bufoff, gbase, voff) do { _Pragma("unroll") for (int _i = 0; _i < 2; ++_i) \
        __builtin_amdgcn_global_load_lds((const unsigned*)((const char*)(gbase) + (voff)[_i]), (PG8_LAS unsigned*)(lds + (bufoff) + ldsw + _i * 8192), 16, 0, 0); } while (0)
#define PG8_LDA(dst, b, h) do { _Pragma("unroll") for (int m = 0; m < 4; ++m) _Pragma("unroll") for (int k = 0; k < 2; ++k) dst[m][k] = *(const PG8_LAS bf16x8*)(lds + PG8_SA(b, h) + aoff + m * 2048 + k * 1024); } while (0)
#define PG8_LDB(dst, b, h) do { _Pragma("unroll") for (int n = 0; n < 2; ++n) _Pragma("unroll") for (int k = 0; k < 2; ++k) dst[n][k] = *(const PG8_LAS bf16x8*)(lds + PG8_SB(b, h) + boff + n * 2048 + k * 1024); } while (0)
#define PG8_MMA(ai, bj, At, Bt) do { __builtin_amdgcn_s_setprio(1); _Pragma("unroll") for (int m = 0; m < 4; ++m) _Pragma("unroll") for (int n = 0; n < 2; ++n) _Pragma("unroll") for (int k = 0; k < 2; ++k) \
        acc[ai][bj][m][n] = __builtin_amdgcn_mfma_f32_16x16x32_bf16(Bt[n][k], At[m][k], acc[ai][bj][m][n], 0, 0, 0); __builtin_amdgcn_s_setprio(0); } while (0)
#define PG8_WAIT_V(n) asm volatile("s_waitcnt vmcnt(" #n ")" ::: "memory")
#define PG8_WAIT_L(n) asm volatile("s_waitcnt lgkmcnt(" #n ")" ::: "memory")
#define PG8_BAR __builtin_amdgcn_s_barrier()
#define PG8_SCHED __builtin_amdgcn_sched_barrier(0)
    Unit cur, nxt; int ui = 0;
    if (!S.next(0, cur)) return;
    f32x4 acc[2][2][4][2];
#pragma unroll
    for (int a = 0; a < 2; ++a)
#pragma unroll
        for (int b = 0; b < 2; ++b)
#pragma unroll
            for (int m = 0; m < 4; ++m)
#pragma unroll
                for (int n = 0; n < 2; ++n) acc[a][b][m][n] = (f32x4){0.f, 0.f, 0.f, 0.f};
    bf16x8 At[4][2], B0[2][2], B1[2][2];
    const char* cA = (const char*)g.A + (size_t)(cur.pm % tps) * tstepA + (size_t)(cur.pm / tps) * sstep; const char* cB = (const char*)g.Bt + (size_t)cur.pn * tstepB + (size_t)(cur.pm / tps) * sstep;
    PG8_STAGE(PG8_SB(0, 0), cB, voffB); PG8_STAGE(PG8_SA(0, 0), cA, voffA); PG8_STAGE(PG8_SB(0, 1), cB + hstepB, voffB); PG8_STAGE(PG8_SA(0, 1), cA + hstepA, voffA);
    if (wr == 1) PG8_BAR;
    PG8_WAIT_V(4); PG8_BAR;
    PG8_STAGE(PG8_SB(1, 0), cB + kstep, voffB); PG8_STAGE(PG8_SA(1, 0), cA + kstep, voffA); PG8_STAGE(PG8_SB(1, 1), cB + hstepB + kstep, voffB);
    PG8_WAIT_V(6); PG8_BAR;
    for (;;) {
        const bool has_next = S.next(ui + 1, nxt);
        const char* nA = has_next ? (const char*)g.A + (size_t)(nxt.pm % tps) * tstepA + (size_t)(nxt.pm / tps) * sstep : cA; const char* nB = has_next ? (const char*)g.Bt + (size_t)nxt.pn * tstepB + (size_t)(nxt.pm / tps) * sstep : cB;
        for (int t = 0; t < nt; t += 2) {
            const bool last = (t == nt - 2);
            const char* a1 = cA + (size_t)(t + 1) * kstep;
            const char* a2 = last ? nA : cA + (size_t)(t + 2) * kstep; const char* b2 = last ? nB : cB + (size_t)(t + 2) * kstep;
            const char* a3 = a2 + kstep; const char* b3 = b2 + kstep;
            PG8_LDB(B0, 0, 0); PG8_SCHED; PG8_LDA(At, 0, 0); PG8_STAGE(PG8_SA(1, 1), a1 + hstepA, voffA);
            PG8_WAIT_L(8); PG8_BAR; PG8_WAIT_L(0); PG8_MMA(0, 0, At, B0); PG8_BAR; PG8_SCHED;
            PG8_LDB(B1, 0, 1); PG8_STAGE(PG8_SB(0, 0), b2, voffB);
            PG8_BAR; PG8_WAIT_L(0); PG8_MMA(0, 1, At, B1); PG8_BAR;
            PG8_LDA(At, 0, 1); PG8_STAGE(PG8_SA(0, 0), a2, voffA);
            PG8_BAR; PG8_WAIT_L(0); PG8_MMA(1, 0, At, B0); PG8_BAR; PG8_SCHED;
            PG8_STAGE(PG8_SB(0, 1), b2 + hstepB, voffB);
            PG8_WAIT_V(6); PG8_BAR; PG8_MMA(1, 1, At, B1); PG8_BAR;
            PG8_LDB(B0, 1, 0); PG8_SCHED; PG8_LDA(At, 1, 0); PG8_STAGE(PG8_SA(0, 1), a2 + hstepA, voffA);
            PG8_WAIT_L(8); PG8_BAR; PG8_WAIT_L(0); PG8_MMA(0, 0, At, B0); PG8_BAR; PG8_SCHED;
            PG8_LDB(B1, 1, 1); PG8_STAGE(PG8_SB(1, 0), b3, voffB);
            PG8_BAR; PG8_WAIT_L(0); PG8_MMA(0, 1, At, B1); PG8_BAR;
            PG8_LDA(At, 1, 1); PG8_STAGE(PG8_SA(1, 0), a3, voffA);
            PG8_BAR; PG8_WAIT_L(0); PG8_MMA(1, 0, At, B0); PG8_BAR; PG8_SCHED;
            PG8_STAGE(PG8_SB(1, 1), b3 + hstepB, voffB);
            PG8_WAIT_V(6); PG8_BAR; PG8_MMA(1, 1, At, B1); PG8_BAR;
        }
        E(acc, cur, wr, wc, fr, fq);
        if (!has_next) break;
#pragma unroll
        for (int a = 0; a < 2; ++a)
#pragma unroll
            for (int b = 0; b < 2; ++b)
#pragma unroll
                for (int m = 0; m < 4; ++m)
#pragma unroll
                    for (int n = 0; n < 2; ++n) acc[a][b][m][n] = (f32x4){0.f, 0.f, 0.f, 0.f};
        cur = nxt; cA = nA; cB = nB; ++ui;
    }
    PG8_WAIT_V(0);
    if (wr == 0) PG8_BAR;
    PG8_BAR;
#undef PG8_SA
#undef PG8_SB
#undef PG8_STAGE
#undef PG8_LDA
#undef PG8_LDB
#undef PG8_MMA
#undef PG8_WAIT_V
#undef PG8_WAIT_L
#undef PG8_BAR
#undef PG8_SCHED
}
}

template <int MODE> struct Epi {
    bf16_t* o0; bf16_t* o1; bf16_t* o2;
    const float* xin_lat; float* xout_lat; const float* xin_ctx; float* xout_ctx; const float* gate;
    DI void operator()(const f32x4 (&acc)[2][2][4][2], const pg8::Unit& u, int wr, int wc, int fr, int fq) const {
#pragma unroll
        for (int ai = 0; ai < 2; ++ai)
#pragma unroll
            for (int m = 0; m < 4; ++m) {
                const int row = u.pm * 256 + ai * 128 + wr * 64 + m * 16 + fr;
#pragma unroll
                for (int bj = 0; bj < 2; ++bj)
#pragma unroll
                    for (int n = 0; n < 2; ++n) {
                        const int col = u.pn * 256 + bj * 128 + wc * 32 + n * 16 + 4 * fq;
                        const f32x4 v = acc[ai][bj][m][n];
                        if (MODE == 0) {
                            uint2 w; w.x = pack2(v[0], v[1]); w.y = pack2(v[2], v[3]);
                            if (col < 1536) *(uint2*)(o0 + (size_t)permrow(row) * 1536 + col) = w;
                            else *(uint2*)(o1 + (size_t)row * 256 + (col - 1536)) = w;
                        } else if (MODE == 7) {
                            uint2 w; w.x = pack2(v[0], v[1]); w.y = pack2(v[2], v[3]);
                            if (col < 1536) *(uint2*)(o0 + (size_t)permrow(row) * 1536 + col) = w;
                            else if (col < 1792) *(uint2*)(o1 + (size_t)row * 256 + (col - 1536)) = w;
                            else if (col < 3712) *(uint2*)(o2 + (size_t)row * 1920 + (col - 1792)) = w;
                        } else if (MODE == 1) {
                            if (col < 1920) { uint2 w; w.x = pack2(v[0], v[1]); w.y = pack2(v[2], v[3]); *(uint2*)(o0 + (size_t)row * 1920 + col) = w; }
                        } else if (MODE == 2) {
                            const float* xi; float* xo; int s;
                            if (row < NLAT) { xi = xin_lat + (size_t)row * 1024 + col; xo = xout_lat + (size_t)row * 1024 + col; s = row >> 12; }
                            else { xi = xin_ctx + (size_t)(row - NLAT) * 1024 + col; xo = xout_ctx + (size_t)(row - NLAT) * 1024 + col; s = 4; }
                            const f32x4 xv = *(const f32x4*)xi; const f32x4 gv = *(const f32x4*)(gate + s * 6144 + col);
                            *(f32x4*)xo = xv + gv * v;
                        } else if (MODE == 4) {
                            uint2 w; w.x = pack2(v[0], v[1]); w.y = pack2(v[2], v[3]);
                            if (col < 1536) *(uint2*)(o0 + (size_t)row * 1536 + col) = w;
                            else if (col < 1920) *(uint2*)(o1 + (size_t)row * 384 + (col - 1536)) = w;
                        } else if (MODE == 5) {
                            const uint2 gw = *(const uint2*)(o1 + (size_t)row * 256 + col);
                            const f32x4 bv = *(const f32x4*)(gate + col);
                            const float g0 = bflo(gw.x), g1 = bfhi(gw.x), g2 = bflo(gw.y), g3 = bfhi(gw.y);
                            uint2 w; w.x = pack2(g0 * sigm(v[0] + bv[0]), g1 * sigm(v[1] + bv[1])); w.y = pack2(g2 * sigm(v[2] + bv[2]), g3 * sigm(v[3] + bv[3]));
                            *(uint2*)(o0 + (size_t)row * 1024 + col) = w;
                            __builtin_amdgcn_sched_barrier(0);
                        } else if (MODE == 6) {
                            *(f32x4*)(xout_lat + (size_t)row * 1024 + col) = v;
                        } else {
                            f32x4 r;
#pragma unroll
                            for (int j = 0; j < 4; ++j) { const float t = fmaxf(v[j], 0.f); r[j] = t * t; }
                            uint2 w; w.x = pack2(r[0], r[1]); w.y = pack2(r[2], r[3]);
                            *(uint2*)(o0 + (size_t)row * 4096 + col) = w;
                        }
                    }
            }
    }
};

DI void ph_mods(const P& p, float* lds) {
    float* sc = lds;
    float* red = lds + 5120;
    float* mod = (float*)(p.ws + OFF_MOD);
    const int tid = tidx(), lane = tid & 63, kg = tid >> 6;
    for (int it = bidx(); it < 192; it += gridDim.x) {
        const int l = it / 96, n0 = (it % 96) * 64;
        __syncthreads();
        for (int i = tid; i < 5120; i += 512) { const int s = i >> 10, k = i & 1023; const float v = s < 4 ? p.c[s * 1024 + k] : p.c_ctx[k]; sc[i] = v * frcp(1.f + __expf(-v)); }
        __syncthreads();
        float a0 = 0.f, a1 = 0.f, a2 = 0.f, a3 = 0.f, a4 = 0.f;
        const float* w = p.w_mod + (size_t)l * 1024 * 6144 + n0 + lane;
        for (int k = kg * 128; k < kg * 128 + 128; ++k) {
            const float wv = w[(size_t)k * 6144];
            a0 += sc[k] * wv; a1 += sc[1024 + k] * wv; a2 += sc[2048 + k] * wv; a3 += sc[3072 + k] * wv; a4 += sc[4096 + k] * wv;
        }
        red[(kg * 5 + 0) * 64 + lane] = a0; red[(kg * 5 + 1) * 64 + lane] = a1; red[(kg * 5 + 2) * 64 + lane] = a2; red[(kg * 5 + 3) * 64 + lane] = a3; red[(kg * 5 + 4) * 64 + lane] = a4;
        __syncthreads();
        if (tid < 320) { const int s = tid >> 6; float t = 0.f;
#pragma unroll
            for (int g = 0; g < 8; ++g) t += red[(g * 5 + s) * 64 + lane];
            mod[(l * 5 + s) * 6144 + n0 + lane] = t + p.b_mod[l * 6144 + n0 + lane]; }
    }
}


DI float swapadd32(float x) {
    const unsigned u = __float_as_uint(x);
    auto r = __builtin_amdgcn_permlane32_swap(u, u, false, false);
    return __uint_as_float(r[0]) + __uint_as_float(r[1]);
}
DI void ph_rwscan2(const P& p, float* lds) {
    float* buf = lds;
    float* ybuf = lds + 24576;
    float* ydummy = lds + 25600;
    const int tid = tidx();
    for (int it = bidx(); it < 192; it += gridDim.x) {
        const int rg = it & 3, dr = (it >> 2) & 1, h = (it >> 3) % 6, b = it / 48;
        __syncthreads();
        const int lane = tid & 63, wv = tid >> 6;
        const int half = lane >> 5, rsel = (lane >> 4) & 1, kc = lane & 15;
        const int rr = 2 * wv + rsel, k0 = (half * 16 + kc) * 2;
        const unsigned char* rwp = p.ws + OFF_RWP;
        bf16_t* YD = (bf16_t*)(p.ws + OFF_R2 + (size_t)dr * ARR);
        f32x2 S = (f32x2){0.f, 0.f};
        uint4 rawA[3], rawB[3];
        auto issue = [&](int j, uint4 (&raw)[3]) {
#pragma unroll
            for (int e = 0; e < 3; ++e) {
                const int q = tid + 512 * e; const int slot = q / 48, rem = q % 48; const int a = rem >> 3, part = rem & 7;
                const int row = rw_row(32 * j + slot, dr, b);
                const unsigned char* base = a == 0 ? rwp + (size_t)(2 + dr) * ARR : a == 1 ? rwp + ARR : a == 2 ? rwp + (size_t)(6 + dr) * ARR : a == 3 ? rwp + (size_t)(4 + dr) * ARR : a == 4 ? rwp : p.ws + OFF_V;
                raw[e] = *(const uint4*)(base + ((size_t)row * 384 + h * 64 + part * 8) * 2);
            }
        };
        auto commit = [&](int bsel, const uint4 (&raw)[3]) {
#pragma unroll
            for (int e = 0; e < 3; ++e) {
                const int q = tid + 512 * e; const int slot = q / 48, rem = q % 48; const int a = rem >> 3, part = rem & 7;
                f32x4 f0 = (f32x4){bflo(raw[e].x), bfhi(raw[e].x), bflo(raw[e].y), bfhi(raw[e].y)}, f1 = (f32x4){bflo(raw[e].z), bfhi(raw[e].z), bflo(raw[e].w), bfhi(raw[e].w)};
                if (a == 0) { f0 = 1.0f - f0; f1 = 1.0f - f1; }
                float* dst = buf + bsel * 12288 + (slot * 6 + a) * 64 + part * 8;
                *(f32x4*)dst = f0; *(f32x4*)(dst + 4) = f1;
            }
        };
        auto flush = [&](int j) {
            const int slot = tid >> 4, r16 = tid & 15;
            const int row = rw_row(32 * j + slot, dr, b);
            YD[(size_t)row * 384 + h * 64 + rg * 16 + r16] = f2bf(ybuf[(j & 1) * 512 + slot * 16 + r16]);
        };
        issue(0, rawA); commit(0, rawA); issue(1, rawA);
        asm volatile("s_waitcnt lgkmcnt(0)" ::: "memory"); __builtin_amdgcn_s_barrier(); asm volatile("" ::: "memory");
        for (int j = 0; j < 136; ++j) {
            if (j + 2 < 136) issue(j + 2, rawB);
            {
                const float* bb = buf + (j & 1) * 12288; float* yb = ybuf + (j & 1) * 512;
                const float* tb0 = bb + k0;
                f32x2 w2 = *(const f32x2*)(tb0), kk2 = *(const f32x2*)(tb0 + 64), kka2 = *(const f32x2*)(tb0 + 128), kt2 = *(const f32x2*)(tb0 + 192), r2 = *(const f32x2*)(tb0 + 256);
                float vv = bb[320 + rg * 16 + rr];
                float* yw = (kc == 0 && half == 0) ? (yb + rr) : (ydummy + tid);
                float yp = 0.f;
#pragma unroll 8
                for (int i = 0; i < 32; ++i) {
                    const int in = i < 31 ? i + 1 : 31;
                    const float* tn = bb + in * 384 + k0;
                    const f32x2 nw2 = *(const f32x2*)(tn), nkk2 = *(const f32x2*)(tn + 64), nkka2 = *(const f32x2*)(tn + 128), nkt2 = *(const f32x2*)(tn + 192), nr2 = *(const f32x2*)(tn + 256);
                    const float nvv = bb[in * 384 + 320 + rg * 16 + rr];
                    const f32x2 td = S * kk2;
                    float d = td[0] + td[1];
                    const f32x2 kv = kt2 * vv;
                    d += dppf<0xB1>(d); yp += dppf<0xB1>(yp);
                    d += dppf<0x4E>(d); yp += dppf<0x4E>(yp);
                    d += dppf<0x141>(d); yp += dppf<0x141>(yp);
                    d += dppf<0x128>(d); yp += dppf<0x128>(yp);
                    d = swapadd32(d); yp = swapadd32(yp);
                    if (i > 0) yw[(i - 1) * 16] = yp;
                    const float sa = -d;
                    S = S * w2 + (kka2 * sa + kv);
                    const f32x2 ty = S * r2;
                    yp = ty[0] + ty[1];
                    w2 = nw2; kk2 = nkk2; kka2 = nkka2; kt2 = nkt2; r2 = nr2; vv = nvv;
                }
                yp = red16(yp); yp = swapadd32(yp);
                yw[31 * 16] = yp;
            }
            if (j + 1 < 136) commit((j + 1) & 1, rawA);
            if (j > 0) flush(j - 1);
#pragma unroll
            for (int e = 0; e < 3; ++e) rawA[e] = rawB[e];
            asm volatile("s_waitcnt lgkmcnt(0)" ::: "memory"); __builtin_amdgcn_s_barrier(); asm volatile("" ::: "memory");
        }
        flush(135);
    }
}

DI void s5_abar(const P& p, int l, int dr, int g, int pp, float& ar, float& ai, float& fr, float& fi) {
    const float step = expf(p.s5_log_step[(l * 2 + dr) * 16 + g]);
    const float lr = p.s5_lam_re[((l * 2 + dr) * 16 + g) * 64 + pp], lim = p.s5_lam_im[((l * 2 + dr) * 16 + g) * 64 + pp];
    const float mag = expf(lr * step);
    ar = mag * cosf(lim * step); ai = mag * sinf(lim * step);
    const float den = lr * lr + lim * lim;
    fr = ((ar - 1.0f) * lr + ai * lim) / den;
    fi = (ai * lr - (ar - 1.0f) * lim) / den;
}

DI void ph_convert(const P& p, int l, float* lds, int part) {
    const int tid = tidx();
    bf16_t* wt = (bf16_t*)(p.ws + OFF_R3);
    const int ntask0 = part == 0 ? 64 * 3712 : 64 * 4096, ntask1 = part == 0 ? 64 * 1024 : 256 * 1024;
    for (int task = bidx() * 512 + tid; task < ntask0 + ntask1; task += gridDim.x * 512) {
        const float* W; int K, N, n, kb, drow; bf16_t* Wt;
        if (task < ntask0) {
            if (part == 0) { K = 1024; N = 3712; n = task % 3712; kb = task / 3712; W = p.w_in + (size_t)l * 1024 * 3712; Wt = wt;
                drow = n < 256 ? 1536 + n : (n < 2176 ? 1792 + (n - 256) : n - 2176); }
            else { K = 1024; N = 4096; n = task & 4095; kb = task >> 12; W = p.w_ff1 + (size_t)l * 1024 * 4096; Wt = wt + 3840 * 1024 + 1024 * 1024; drow = n; }
        } else {
            const int t2 = task - ntask0;
            if (part == 0) { K = 1024; N = 1024; n = t2 & 1023; kb = t2 >> 10; W = p.w_out + (size_t)l * 1024 * 1024; Wt = wt + 3840 * 1024; drow = n; }
            else { K = 4096; N = 1024; n = t2 & 1023; kb = t2 >> 10; W = p.w_ff2 + (size_t)l * 4096 * 1024; Wt = wt + 3840 * 1024 + 1024 * 1024 + 4096 * 1024; drow = n; }
        }
        const float* src = W + (size_t)(kb * 16) * N + n;
        float v[16];
#pragma unroll
        for (int j = 0; j < 16; ++j) v[j] = __builtin_nontemporal_load(src + (size_t)j * N);
        bf16_t* dst = Wt + (size_t)drow * K + kb * 16;
        *(uint4*)dst = make_uint4(pack2(v[0], v[1]), pack2(v[2], v[3]), pack2(v[4], v[5]), pack2(v[6], v[7]));
        *(uint4*)(dst + 8) = make_uint4(pack2(v[8], v[9]), pack2(v[10], v[11]), pack2(v[12], v[13]), pack2(v[14], v[15]));
    }
    if (part == 0) {
        bf16_t* waux = (bf16_t*)(p.ws + OFF_WAUX); bf16_t* wglu = (bf16_t*)(p.ws + OFF_WGLU);
        for (int i = bidx() * 512 + tid; i < 2048 * 384 + 65536 + 65536; i += gridDim.x * 512) {
            if (i < 2048 * 384) {
                const int n = i / 384, k = i % 384; float v = 0.f;
                if (n < 768) { const int dr = n / 384, c = n % 384; if ((k >> 6) == dr) v = p.rwkv_w2[((size_t)(l * 2 + dr) * 64 + (k & 63)) * 384 + c]; }
                else if (n < 1536) { const int dr = (n - 768) / 384, c = (n - 768) % 384; if ((k >> 6) == 2 + dr) v = p.rwkv_a2[((size_t)(l * 2 + dr) * 64 + (k & 63)) * 384 + c]; }
                else if (n < 1920) { if (k >= 256) v = p.rwkv_g2[((size_t)l * 128 + (k - 256)) * 384 + (n - 1536)]; }
                waux[i] = f2bf(v);
            } else if (i < 2048 * 384 + 65536) { const int j = i - 2048 * 384; const int n = j >> 8, k = j & 255; wglu[j] = f2bf(p.s5_w_glu[((size_t)l * 256 + k) * 256 + n]); }
            else { wglu[i - 2048 * 384] = 0; }
        }
        bf16_t* s5w = (bf16_t*)(p.ws + OFF_S5W);
        for (int i = bidx() * 512 + tid; i < 32 * 4096 + 32 * 2048; i += gridDim.x * 512) {
            if (i < 32 * 4096) {
                const int dg = i >> 12, pq = (i >> 5) & 127, hq = i & 31; const int dr = dg >> 4, g = dg & 15, pp = pq & 63;
                float v = 0.f;
                if (hq < 16) { float ar, ai, fr, fi; s5_abar(p, l, dr, g, pp, ar, ai, fr, fi);
                    const size_t bi = ((size_t)((l * 2 + dr) * 16 + g) * 64 + pp) * 16 + hq; const float br = p.s5_b_re[bi], bm = p.s5_b_im[bi];
                    v = pq < 64 ? fr * br - fi * bm : fr * bm + fi * br; }
                s5w[i] = f2bf(v);
            } else {
                const int j = i - 32 * 4096; const int dg = j >> 11, hh = (j >> 7) & 15, pq = j & 127; const int dr = dg >> 4, g = dg & 15;
                const size_t ci = (size_t)((l * 2 + dr) * 16 + g) * 1024 + hh * 64 + (pq & 63);
                s5w[i] = f2bf(pq < 64 ? p.s5_c_re[ci] : -p.s5_c_im[ci]);
            }
        }
    }
}

DI void ph_norm(const P& p, int l, int which, int nrows) {
    const float* g = (which ? p.norm2_g : p.norm1_g) + l * 1024;
    const int shc = which ? 3 : 0, scc = shc + 1;
    const int tid = tidx(), lane = tid & 63;
    const float* mod = (const float*)(p.ws + OFF_MOD);
    const float* xc = (const float*)(p.ws + OFF_XC);
    bf16_t* H = (bf16_t*)(p.ws + OFF_R1);
    const bool from_inputs = (l == 0 && which == 0);
    for (int m0 = (bidx() * 8 + (tid >> 6)) * 2; m0 < nrows; m0 += gridDim.x * 16) {
        f32x4 v[2][4]; float ss[2]; int sidx[2];
#pragma unroll
        for (int u = 0; u < 2; ++u) {
            const int m = m0 + u; const float* src;
            if (m < NLAT) { src = (from_inputs ? p.x : p.out) + (size_t)m * 1024; sidx[u] = m >> 12; }
            else { src = (from_inputs ? p.ctx : xc) + (size_t)(m - NLAT) * 1024; sidx[u] = 4; }
            ss[u] = 0.f;
            const bool addA = (l == 1 && which == 0 && m >= NLAT);
            const bool addB = (l == 0 && which == 1 && m >= NLAT);
            if (addB) src = p.ctx + (size_t)(m - NLAT) * 1024;
#pragma unroll
            for (int j = 0; j < 4; ++j) { v[u][j] = *(const f32x4*)(src + j * 256 + lane * 4);
                if (addA || addB) { const int col = j * 256 + lane * 4; f32x4 acc = (f32x4){0.f, 0.f, 0.f, 0.f};
                    const int nsl = addA ? 8 : 4;
                    for (int sl = 0; sl < nsl; ++sl) acc += *(const f32x4*)((const float*)(p.ws + OFF_R2) + ((size_t)sl * 1024 + (m - NLAT)) * 1024 + col);
                    v[u][j] += *(const f32x4*)(mod + (0 * 5 + 4) * 6144 + (addA ? 5 : 2) * 1024 + col) * acc;
                    if (addB) *(f32x4*)((float*)(p.ws + OFF_XC) + (size_t)(m - NLAT) * 1024 + col) = v[u][j]; } ss[u] += v[u][j][0] * v[u][j][0] + v[u][j][1] * v[u][j][1] + v[u][j][2] * v[u][j][2] + v[u][j][3] * v[u][j][3]; }
        }
#pragma unroll
        for (int u = 0; u < 2; ++u) {
            const int m = m0 + u;
            const float rstd = rsqrtf(wave_sum(ss[u]) * (1.0f / 1024.0f) + 1e-6f);
            const float* md = mod + (l * 5 + sidx[u]) * 6144;
#pragma unroll
            for (int j = 0; j < 4; ++j) {
                const int col = j * 256 + lane * 4;
                const f32x4 g4 = *(const f32x4*)(g + col), sh4 = *(const f32x4*)(md + shc * 1024 + col), sc4 = *(const f32x4*)(md + scc * 1024 + col);
                f32x4 h;
#pragma unroll
                for (int e = 0; e < 4; ++e) h[e] = v[u][j][e] * rstd * g4[e] * (1.0f + sc4[e]) + sh4[e];
                uint2 w; w.x = pack2(h[0], h[1]); w.y = pack2(h[2], h[3]);
                *(uint2*)(H + (size_t)m * 1024 + col) = w;
            }
        }
    }
}

DI void ph_rwp1(const P& p, int l, float* lds) {
    const int tid = tidx();
    const float* mu0 = p.rwkv_mu + (size_t)l * 2 * 1536; const float* mu1 = mu0 + 1536;
    const bf16_t* ZRW = (const bf16_t*)(p.ws + OFF_R2);
    bf16_t* Vv = (bf16_t*)(p.ws + OFF_V); bf16_t* AUXA = (bf16_t*)(p.ws + OFF_AUXA);
    bf16_t* Rr = (bf16_t*)(p.ws + OFF_RWP); bf16_t* KK = (bf16_t*)(p.ws + OFF_RWP + ARR); bf16_t* KTMP = (bf16_t*)(p.ws + OFF_RWP + 4 * ARR);
    const float* k_k = p.rwkv_k_k + l * 384;
    for (int task = bidx() * 512 + tid; task < NTOK * 192; task += gridDim.x * 512) {
        const int row = task / 192, cc = task % 192; const int col = cc * 8;
        int pos, slen;
        if (row < NLAT) { pos = row & 4095; slen = 4096; } else { pos = (row - NLAT) & 255; slen = 256; }
        const bf16_t* zr = ZRW + (size_t)row * 1536 + col;
        const uint4 z0 = make_uint4(0, 0, 0, 0);
        const uint4 zc = *(const uint4*)zr; const uint4 zp = pos > 0 ? *(const uint4*)(zr - 1536) : z0; const uint4 zn = (pos + 1 < slen) ? *(const uint4*)(zr + 1536) : z0;
        const unsigned cw[4] = {zc.x, zc.y, zc.z, zc.w}, pw[4] = {zp.x, zp.y, zp.z, zp.w}, nw[4] = {zn.x, zn.y, zn.z, zn.w};
        const f32x4 m0a = *(const f32x4*)(mu0 + col), m0b = *(const f32x4*)(mu0 + col + 4), m1a = *(const f32x4*)(mu1 + col), m1b = *(const f32x4*)(mu1 + col + 4);
        float o[8];
#pragma unroll
        for (int e = 0; e < 4; ++e) {
            const float c0 = bflo(cw[e]), c1 = bfhi(cw[e]), q0 = bflo(pw[e]), q1 = bfhi(pw[e]), n0 = bflo(nw[e]), n1 = bfhi(nw[e]);
            const float ma0 = e < 2 ? m0a[2 * e] : m0b[2 * e - 4], ma1 = e < 2 ? m0a[2 * e + 1] : m0b[2 * e - 3];
            const float mb0 = e < 2 ? m1a[2 * e] : m1b[2 * e - 4], mb1 = e < 2 ? m1a[2 * e + 1] : m1b[2 * e - 3];
            o[2 * e] = c0 + ma0 * (q0 - c0) + mb0 * (n0 - c0);
            o[2 * e + 1] = c1 + ma1 * (q1 - c1) + mb1 * (n1 - c1);
        }
        const int seg = cc / 48, c = (cc % 48) * 8;
        const size_t oo = (size_t)row * 384 + c;
        const f32x4 kka = *(const f32x4*)(k_k + c), kkb = *(const f32x4*)(k_k + c + 4);
        float kq[8]; float ss = 0.f;
#pragma unroll
        for (int e = 0; e < 8; ++e) { kq[e] = o[e] * (e < 4 ? kka[e] : kkb[e - 4]); ss += kq[e] * kq[e]; }
        ss += dppf<0xB1>(ss); ss += dppf<0x4E>(ss); ss += dppf<0x141>(ss);
        const float iv = rsqrtf(fmaxf(ss, 1e-24f));
        const uint4 po = make_uint4(pack2(o[0], o[1]), pack2(o[2], o[3]), pack2(o[4], o[5]), pack2(o[6], o[7]));
        if (seg == 0) *(uint4*)(Rr + oo) = po;
        else if (seg == 1) { *(uint4*)(KTMP + oo) = po;
            *(uint4*)(KK + oo) = make_uint4(pack2(kq[0] * iv, kq[1] * iv), pack2(kq[2] * iv, kq[3] * iv), pack2(kq[4] * iv, kq[5] * iv), pack2(kq[6] * iv, kq[7] * iv)); }
        else if (seg == 2) *(uint4*)(Vv + oo) = po;
        else {
            float a[8];
#pragma unroll
            for (int e = 0; e < 8; ++e) a[e] = c < 128 ? tanh_fast(o[e]) : (c >= 256 ? sigm(o[e]) : o[e]);
            *(uint4*)(AUXA + oo) = make_uint4(pack2(a[0], a[1]), pack2(a[2], a[3]), pack2(a[4], a[5]), pack2(a[6], a[7]));
        }
    }
}
DI void ph_rwp2(const P& p, int l) {
    const int tid = tidx(), lane = tid & 63, sub = lane >> 4, l16 = lane & 15;
    const bf16_t* PRE = (const bf16_t*)(p.ws + OFF_R2);
    const bf16_t* Rr = (const bf16_t*)(p.ws + OFF_RWP); const bf16_t* KK = (const bf16_t*)(p.ws + OFF_RWP + ARR);
    bf16_t* KT0 = (bf16_t*)(p.ws + OFF_RWP + 4 * ARR);
    float* CB = (float*)(p.ws + OFF_CB);
    for (int grp = bidx() * 8 + (tid >> 6); grp < NTOK * 6 / 4; grp += gridDim.x * 8) {
        const int task = grp * 4 + sub; const int row = task / 6, h = task % 6, c = h * 64 + l16 * 4;
        const size_t o = (size_t)row * 384 + c;
        const uint2 kx = *(const uint2*)(KT0 + o), kkx = *(const uint2*)(KK + o), rx = *(const uint2*)(Rr + o);
        uint2 pw[2], pa[2];
#pragma unroll
        for (int dr = 0; dr < 2; ++dr) { pw[dr] = *(const uint2*)(PRE + (size_t)row * 1536 + dr * 384 + c); pa[dr] = *(const uint2*)(PRE + (size_t)row * 1536 + 768 + dr * 384 + c); }
        const float k4[4] = {bflo(kx.x), bfhi(kx.x), bflo(kx.y), bfhi(kx.y)}, kk4[4] = {bflo(kkx.x), bfhi(kkx.x), bflo(kkx.y), bfhi(kkx.y)}, r4[4] = {bflo(rx.x), bfhi(rx.x), bflo(rx.y), bfhi(rx.y)};
        const f32x4 ka4 = *(const f32x4*)(p.rwkv_k_a + l * 384 + c), rk4 = *(const f32x4*)(p.rwkv_r_k + l * 384 + c);
        float bsum = 0.f;
#pragma unroll
        for (int dr = 0; dr < 2; ++dr) {
            const f32x4 w04 = *(const f32x4*)(p.rwkv_w0 + (l * 2 + dr) * 384 + c), a04 = *(const f32x4*)(p.rwkv_a0 + (l * 2 + dr) * 384 + c);
            const float pw4[4] = {bflo(pw[dr].x), bfhi(pw[dr].x), bflo(pw[dr].y), bfhi(pw[dr].y)}, pa4[4] = {bflo(pa[dr].x), bfhi(pa[dr].x), bflo(pa[dr].y), bfhi(pa[dr].y)};
            float ow[4], okt[4], oka[4];
#pragma unroll
            for (int e = 0; e < 4; ++e) {
                const float ew = 0.60653066f * sigm(w04[e] + pw4[e]);
                ow[e] = 1.0f - __expf(-ew);
                const float a = sigm(a04[e] + pa4[e]);
                okt[e] = k4[e] * (1.0f + (a - 1.0f) * ka4[e]);
                oka[e] = kk4[e] * a;
                bsum += r4[e] * okt[e] * rk4[e];
            }
            uint2 t; t.x = pack2(ow[0], ow[1]); t.y = pack2(ow[2], ow[3]); *(uint2*)((bf16_t*)(p.ws + OFF_RWP + (size_t)(2 + dr) * ARR) + o) = t;
            t.x = pack2(okt[0], okt[1]); t.y = pack2(okt[2], okt[3]); *(uint2*)((bf16_t*)(p.ws + OFF_RWP + (size_t)(4 + dr) * ARR) + o) = t;
            t.x = pack2(oka[0], oka[1]); t.y = pack2(oka[2], oka[3]); *(uint2*)((bf16_t*)(p.ws + OFF_RWP + (size_t)(6 + dr) * ARR) + o) = t;
        }
        bsum = red16(bsum);
        if (l16 == 0) CB[(size_t)row * 6 + h] = bsum;
    }
}

DI void ph_rwscan(const P& p, float* lds) {
    float* buf = lds;
    float* ybuf = lds + 24576;
    float* ydummy = lds + 26624;
    const int tid = tidx();
    for (int cb = bidx(); cb < 192; cb += gridDim.x) {
        const int it = (((cb & 7) * 6 + (cb >> 5)) << 2) | ((cb >> 3) & 3);
        const int rg = it & 3, dr = (it >> 2) & 1, h = (it >> 3) % 6, b = it / 48;
        __syncthreads();
        const bool consumer = tid < 256;
        const int rr = (tid >> 4) & 15, kc = tid & 15, lt = tid & 255;
        const unsigned char* rwp = p.ws + OFF_RWP;
        bf16_t* YD = (bf16_t*)(p.ws + OFF_R2 + (size_t)dr * ARR);
        f32x2 S01 = (f32x2){0.f, 0.f}, S23 = (f32x2){0.f, 0.f};
        uint4 rawA[6], rawB[6];
        const int lslot = lt >> 3, lpart = lt & 7;
        auto issue = [&](int j, uint4 (&raw)[6]) {
            const int row = rw_row(32 * j + lslot, dr, b);
            const size_t off = ((size_t)row * 384 + h * 64 + lpart * 8) * 2;
            raw[0] = *(const uint4*)(rwp + (size_t)(2 + dr) * ARR + off);
            raw[1] = *(const uint4*)(rwp + ARR + off);
            raw[2] = *(const uint4*)(rwp + (size_t)(6 + dr) * ARR + off);
            raw[3] = *(const uint4*)(rwp + (size_t)(4 + dr) * ARR + off);
            raw[4] = *(const uint4*)(rwp + off);
            raw[5] = *(const uint4*)(p.ws + OFF_V + off);
        };
        auto commit = [&](int bsel, const uint4 (&raw)[6]) {
            float* dst = buf + bsel * 12288 + lslot * 384 + lpart * 8;
#pragma unroll
            for (int a = 0; a < 6; ++a) {
                f32x4 f0 = (f32x4){bflo(raw[a].x), bfhi(raw[a].x), bflo(raw[a].y), bfhi(raw[a].y)}, f1 = (f32x4){bflo(raw[a].z), bfhi(raw[a].z), bflo(raw[a].w), bfhi(raw[a].w)};
                if (a == 0) { f0 = 1.0f - f0; f1 = 1.0f - f1; }
                *(f32x4*)(dst + a * 64) = f0; *(f32x4*)(dst + a * 64 + 4) = f1;
            }
        };
        auto flush = [&](int j) {
#pragma unroll
            for (int e = 0; e < 2; ++e) {
                const int q = lt + 256 * e; const int slot = q >> 4, r16 = q & 15;
                const int row = rw_row(32 * j + slot, dr, b);
                const f32x2 yh = *(const f32x2*)(ybuf + (j & 1) * 1024 + (slot * 16 + r16) * 2);
                YD[(size_t)row * 384 + h * 64 + rg * 16 + r16] = f2bf(yh[0] + yh[1]);
            }
        };
        if (!consumer) { issue(0, rawA); commit(0, rawA); issue(1, rawA); }
        asm volatile("s_waitcnt lgkmcnt(0)" ::: "memory"); __builtin_amdgcn_s_barrier(); asm volatile("" ::: "memory");
        for (int j = 0; j < 136; ++j) {
            if (consumer) {
                const float* bb = buf + (j & 1) * 12288; float* yb = ybuf + (j & 1) * 1024;
                const float* tb0 = bb + kc * 4;
                f32x4 w4 = *(const f32x4*)(tb0), kk4 = *(const f32x4*)(tb0 + 64), kka4 = *(const f32x4*)(tb0 + 128), kt4 = *(const f32x4*)(tb0 + 192), r4 = *(const f32x4*)(tb0 + 256);
                float vv = bb[320 + rg * 16 + rr];
                float* yw = ((kc & 7) == 0) ? (yb + rr * 2 + (kc >> 3)) : (ydummy + tid);
                float yp = 0.f;
#pragma unroll
                for (int i = 0; i < 32; ++i) {
                    const int in = i < 31 ? i + 1 : 31;
                    const float* tn = bb + in * 384 + kc * 4;
                    const f32x4 nw4 = *(const f32x4*)(tn), nkk4 = *(const f32x4*)(tn + 64), nkka4 = *(const f32x4*)(tn + 128), nkt4 = *(const f32x4*)(tn + 192), nr4 = *(const f32x4*)(tn + 256);
                    const float nvv = bb[in * 384 + 320 + rg * 16 + rr];
                    f32x2 td = S01 * (f32x2){kk4[0], kk4[1]}; td = S23 * (f32x2){kk4[2], kk4[3]} + td;
                    float d = td[0] + td[1];
                    const f32x2 kv01 = (f32x2){kt4[0], kt4[1]} * vv, kv23 = (f32x2){kt4[2], kt4[3]} * vv;
                    d += dppf<0xB1>(d); yp += dppf<0xB1>(yp);
                    d += dppf<0x4E>(d); yp += dppf<0x4E>(yp);
                    d += dppf<0x141>(d); yp += dppf<0x141>(yp);
                    d += dppf<0x128>(d);
                    if (i > 0) yw[(i - 1) * 32] = yp;
                    const float sa = -d;
                    S01 = S01 * (f32x2){w4[0], w4[1]} + ((f32x2){kka4[0], kka4[1]} * sa + kv01);
                    S23 = S23 * (f32x2){w4[2], w4[3]} + ((f32x2){kka4[2], kka4[3]} * sa + kv23);
                    f32x2 ty = S01 * (f32x2){r4[0], r4[1]}; ty = S23 * (f32x2){r4[2], r4[3]} + ty;
                    yp = ty[0] + ty[1];
                    w4 = nw4; kk4 = nkk4; kka4 = nkka4; kt4 = nkt4; r4 = nr4; vv = nvv;
                }
                yp += dppf<0xB1>(yp); yp += dppf<0x4E>(yp); yp += dppf<0x141>(yp);
                yw[31 * 32] = yp;
            } else {
                if (j + 2 < 136) issue(j + 2, rawB);
                if (j + 1 < 136) commit((j + 1) & 1, rawA);
                if (j > 0) flush(j - 1);
#pragma unroll
                for (int e = 0; e < 6; ++e) rawA[e] = rawB[e];
            }
            asm volatile("s_waitcnt lgkmcnt(0)" ::: "memory"); __builtin_amdgcn_s_barrier(); asm volatile("" ::: "memory");
        }
        if (!consumer) flush(135);
    }
}


DI void ph_rwscan3(const P& p, float* lds) {
    float* buf = lds;
    float* ybuf = lds + 24576;
    float* ydummy = lds + 25600;
    float* abuf = lds + 26624;
    const int tid = tidx();
    for (int it = bidx(); it < 192; it += gridDim.x) {
        const int rg = it & 3, dr = (it >> 2) & 1, h = (it >> 3) % 6, b = it / 48;
        __syncthreads();
        const bool consumer = tid < 256;
        const int rr = (tid >> 4) & 15, kc = tid & 15, lt = tid & 255;
        const int lslot = lt >> 3, lpart = lt & 7;
        const unsigned char* rwp = p.ws + OFF_RWP;
        bf16_t* YD = (bf16_t*)(p.ws + OFF_R2 + (size_t)dr * ARR);
        f32x2 S01 = (f32x2){0.f, 0.f}, S23 = (f32x2){0.f, 0.f};
        float Dred = 0.f, sa_prev = 0.f, vv_prev = 0.f, a_cur = 0.f, b_cur = 0.f;
        uint4 rawA[6], rawB[6];
        auto issue = [&](int j, uint4 (&raw)[6]) {
            const int step = 32 * j + lslot;
            const int row = rw_row(step, dr, b);
            const int rown = rw_row(step < 4351 ? step + 1 : step, dr, b);
            const size_t off = ((size_t)row * 384 + h * 64 + lpart * 8) * 2, offn = ((size_t)rown * 384 + h * 64 + lpart * 8) * 2;
            raw[0] = *(const uint4*)(rwp + (size_t)(2 + dr) * ARR + off);
            raw[1] = *(const uint4*)(rwp + ARR + offn);
            raw[2] = *(const uint4*)(rwp + (size_t)(6 + dr) * ARR + off);
            raw[3] = *(const uint4*)(rwp + (size_t)(4 + dr) * ARR + off);
            raw[4] = *(const uint4*)(rwp + off);
            raw[5] = *(const uint4*)(p.ws + OFF_V + off);
        };
        auto commit = [&](int bsel, const uint4 (&raw)[6]) {
            f32x4 f[6][2];
#pragma unroll
            for (int a = 0; a < 6; ++a) { f[a][0] = (f32x4){bflo(raw[a].x), bfhi(raw[a].x), bflo(raw[a].y), bfhi(raw[a].y)}; f[a][1] = (f32x4){bflo(raw[a].z), bfhi(raw[a].z), bflo(raw[a].w), bfhi(raw[a].w)}; }
            f[0][0] = 1.0f - f[0][0]; f[0][1] = 1.0f - f[0][1];
            const f32x4 wk0 = f[0][0] * f[1][0], wk1 = f[0][1] * f[1][1];
            const f32x4 pa = f[2][0] * f[1][0] + f[2][1] * f[1][1], pb = f[3][0] * f[1][0] + f[3][1] * f[1][1];
            float an = (pa[0] + pa[1]) + (pa[2] + pa[3]), bn = (pb[0] + pb[1]) + (pb[2] + pb[3]);
            an += dppf<0xB1>(an); bn += dppf<0xB1>(bn); an += dppf<0x4E>(an); bn += dppf<0x4E>(bn); an += dppf<0x141>(an); bn += dppf<0x141>(bn);
            float* dst = buf + bsel * 12288 + lslot * 384 + lpart * 8;
            *(f32x4*)(dst) = f[0][0]; *(f32x4*)(dst + 4) = f[0][1];
            *(f32x4*)(dst + 64) = wk0; *(f32x4*)(dst + 68) = wk1;
            *(f32x4*)(dst + 128) = f[2][0]; *(f32x4*)(dst + 132) = f[2][1];
            *(f32x4*)(dst + 192) = f[3][0]; *(f32x4*)(dst + 196) = f[3][1];
            *(f32x4*)(dst + 256) = f[4][0]; *(f32x4*)(dst + 260) = f[4][1];
            *(f32x4*)(dst + 320) = f[5][0]; *(f32x4*)(dst + 324) = f[5][1];
            if (lpart == 0) { abuf[(bsel * 32 + lslot) * 2] = an; abuf[(bsel * 32 + lslot) * 2 + 1] = bn; }
        };
        auto flush = [&](int j) {
#pragma unroll
            for (int e = 0; e < 2; ++e) {
                const int q = lt + 256 * e; const int slot = q >> 4, r16 = q & 15;
                const int row = rw_row(32 * j + slot, dr, b);
                YD[(size_t)row * 384 + h * 64 + rg * 16 + r16] = f2bf(ybuf[(j & 1) * 512 + slot * 16 + r16]);
            }
        };
        if (!consumer) { issue(0, rawA); commit(0, rawA); issue(1, rawA); }
        lds_barrier();
        for (int j = 0; j < 136; ++j) {
            if (consumer) {
                const float* bb = buf + (j & 1) * 12288; float* yb = ybuf + (j & 1) * 512; const float* ab = abuf + (j & 1) * 64;
                const float* tb0 = bb + kc * 4;
                f32x4 w4 = *(const f32x4*)(tb0), wk4 = *(const f32x4*)(tb0 + 64), kka4 = *(const f32x4*)(tb0 + 128), kt4 = *(const f32x4*)(tb0 + 192), r4 = *(const f32x4*)(tb0 + 256);
                float vv = bb[320 + rg * 16 + rr];
                f32x2 abn = *(const f32x2*)ab;
                float* yw = (kc == 0) ? (yb + rr) : (ydummy + tid);
                float yp = 0.f;
#pragma unroll 8
                for (int i = 0; i < 32; ++i) {
                    const int in = i < 31 ? i + 1 : 31;
                    const float* tn = bb + in * 384 + kc * 4;
                    const f32x4 nw4 = *(const f32x4*)(tn), nwk4 = *(const f32x4*)(tn + 64), nkka4 = *(const f32x4*)(tn + 128), nkt4 = *(const f32x4*)(tn + 192), nr4 = *(const f32x4*)(tn + 256);
                    const float nvv = bb[in * 384 + 320 + rg * 16 + rr];
                    const f32x2 nabn = *(const f32x2*)(ab + in * 2);
                    const float d = Dred + sa_prev * a_cur + vv_prev * b_cur;
                    const float sa = -d;
                    f32x2 tp = S01 * (f32x2){wk4[0], wk4[1]}; tp = S23 * (f32x2){wk4[2], wk4[3]} + tp;
                    float pn = tp[0] + tp[1];
                    const f32x2 kv01 = (f32x2){kt4[0], kt4[1]} * vv, kv23 = (f32x2){kt4[2], kt4[3]} * vv;
                    S01 = S01 * (f32x2){w4[0], w4[1]} + ((f32x2){kka4[0], kka4[1]} * sa + kv01);
                    S23 = S23 * (f32x2){w4[2], w4[3]} + ((f32x2){kka4[2], kka4[3]} * sa + kv23);
                    pn += dppf<0xB1>(pn); yp += dppf<0xB1>(yp);
                    pn += dppf<0x4E>(pn); yp += dppf<0x4E>(yp);
                    pn += dppf<0x141>(pn); yp += dppf<0x141>(yp);
                    pn += dppf<0x128>(pn); yp += dppf<0x128>(yp);
                    if (i > 0) yw[(i - 1) * 16] = yp;
                    f32x2 ty = S01 * (f32x2){r4[0], r4[1]}; ty = S23 * (f32x2){r4[2], r4[3]} + ty;
                    yp = ty[0] + ty[1];
                    Dred = pn; sa_prev = sa; vv_prev = vv; a_cur = abn[0]; b_cur = abn[1];
                    w4 = nw4; wk4 = nwk4; kka4 = nkka4; kt4 = nkt4; r4 = nr4; vv = nvv; abn = nabn;
                }
                yp = red16(yp);
                yw[31 * 16] = yp;
            } else {
                if (j + 2 < 136) issue(j + 2, rawB);
                if (j + 1 < 136) commit((j + 1) & 1, rawA);
                if (j > 0) flush(j - 1);
#pragma unroll
                for (int e = 0; e < 6; ++e) rawA[e] = rawB[e];
            }
            lds_barrier();
        }
        if (!consumer) flush(135);
    }
}

template <bool RO> DI void ph_s5(const P& p, int l, float* lds, int bstart, int bstride) {
    const int tid = tidx(), lane = tid & 63, wv = tid >> 6, fr = lane & 15, fq = lane >> 4;
    float* BU = lds + wv * 2048;
    bf16_t* Hb = (bf16_t*)(lds + 8 * 2048) + wv * (16 * 136);
    float* ysum = lds + 8 * 2048 + 8 * 16 * 136 / 2;
    const bf16_t* ZS5 = (const bf16_t*)(p.ws + OFF_ZS5);
    bf16_t* G5 = (bf16_t*)(p.ws + OFF_G5);
    float2* ST = (float2*)(p.ws + OFF_S5ST);
    const bf16_t* s5w = (const bf16_t*)(p.ws + OFF_S5W);
    int cur_gq = -1;
    float ar = 0.f, ai = 0.f, fr_ = 0.f, fi_ = 0.f;
    bf16x8 bfrag[8]; bf16x8 cfrag[4];
    for (int it = bstart; it < 1088; it += bstride) {
        const int gq = it & 3; const int rem = it >> 2; const int cidx = rem % 68, b = rem / 68;
        const int gl_ = wv & 3, dr = wv >> 2, g = gq * 4 + gl_, dg = dr * 16 + g;
        const int row0 = cidx < 4 ? NLAT + b * 256 + cidx * 64 : b * 4096 + (cidx - 4) * 64;
        lds_barrier();
        if (RO) {
#pragma unroll
            for (int i = 0; i < 8; ++i) ysum[tid + 512 * i] = 0.f;
        }
        if (gq != cur_gq) {
            cur_gq = gq;
            s5_abar(p, l, dr, g, lane, ar, ai, fr_, fi_);
#pragma unroll
            for (int nt = 0; nt < 8; ++nt) bfrag[nt] = *(const bf16x8*)(s5w + (size_t)dg * 4096 + (16 * nt + fr) * 32 + 8 * fq);
            if (RO) {
#pragma unroll
                for (int ks = 0; ks < 4; ++ks) cfrag[ks] = *(const bf16x8*)(s5w + 32 * 4096 + (size_t)dg * 2048 + fr * 128 + 32 * ks + 8 * fq);
            }
        }
        float hr = 0.f, hi = 0.f;
        const size_t sidx = ((size_t)((b * 2 + dr) * 68 + cidx) * 16 + g) * 64 + lane;
        if (RO) { const float2 s0 = ST[sidx]; hr = s0.x; hi = s0.y; }
        lds_barrier();
        bf16x8 afr[4];
#pragma unroll
        for (int sb = 0; sb < 4; ++sb) {
            const int s_a = 16 * sb + fr; const int t_a = dr ? 63 - s_a : s_a;
            afr[sb] = (bf16x8){0, 0, 0, 0, 0, 0, 0, 0};
            if (fq < 2) afr[sb] = *(const bf16x8*)(ZS5 + (size_t)(row0 + t_a) * 256 + g * 16 + 8 * fq);
        }
#pragma unroll
        for (int sb = 0; sb < 4; ++sb) {
            const bf16x8 afrag = afr[sb];
#pragma unroll
            for (int nt = 0; nt < 8; ++nt) {
                f32x4 acc = __builtin_amdgcn_mfma_f32_16x16x32_bf16(afrag, bfrag[nt], (f32x4){0.f, 0.f, 0.f, 0.f}, 0, 0, 0);
#pragma unroll
                for (int r = 0; r < 4; ++r) BU[(fq * 4 + r) * 128 + 16 * nt + fr] = acc[r];
            }
            asm volatile("s_waitcnt lgkmcnt(0)" ::: "memory");
            float burv[16], buiv[16];
#pragma unroll
            for (int sl = 0; sl < 16; ++sl) { burv[sl] = BU[sl * 128 + lane]; buiv[sl] = BU[sl * 128 + 64 + lane]; }
#pragma unroll
            for (int sl = 0; sl < 16; ++sl) {
                const float bur = burv[sl], bui = buiv[sl];
                const float nhr = ar * hr - ai * hi + bur, nhi = ar * hi + ai * hr + bui;
                hr = nhr; hi = nhi;
                if (RO) { Hb[sl * 136 + lane] = f2bf(hr); Hb[sl * 136 + 64 + lane] = f2bf(hi); }
            }
            if (RO) {
                asm volatile("s_waitcnt lgkmcnt(0)" ::: "memory");
                f32x4 acc = (f32x4){0.f, 0.f, 0.f, 0.f};
#pragma unroll
                for (int ks = 0; ks < 4; ++ks) acc = __builtin_amdgcn_mfma_f32_16x16x32_bf16(*(const bf16x8*)(Hb + fr * 136 + 32 * ks + 8 * fq), cfrag[ks], acc, 0, 0, 0);
#pragma unroll
                for (int r = 0; r < 4; ++r) { const int s2 = 16 * sb + fq * 4 + r; const int t2 = dr ? 63 - s2 : s2; atomicAdd(&ysum[t2 * 64 + gl_ * 16 + fr], acc[r]); }
                asm volatile("s_waitcnt lgkmcnt(0)" ::: "memory");
            }
        }
        if (!RO) { ST[sidx] = make_float2(hr, hi); }
        else {
            lds_barrier();
            const float* dd = p.s5_d + l * 256 + gq * 64;
#pragma unroll
            for (int i = 0; i < 8; ++i) { const int idx = tid + 512 * i; const int t = idx >> 6, ch = idx & 63;
                const float u = bf2f(ZS5[(size_t)(row0 + t) * 256 + gq * 64 + ch]);
                const float xv = ysum[idx] + dd[ch] * u;
                const float ge = 0.5f * xv * (1.0f + tanh_fast(0.7978845608f * (xv + 0.044715f * xv * xv * xv)));
                G5[(size_t)(row0 + t) * 256 + gq * 64 + ch] = f2bf(ge); }
        }
    }
}

DI void ph_s5carry(const P& p, int l, int bstart, int bstride) {
    float2* ST = (float2*)(p.ws + OFF_S5ST);
    for (int i = bstart * 512 + tidx(); i < 8192; i += bstride * 512) {
        const int pp = i & 63, g = (i >> 6) & 15, dr = (i >> 10) & 1, b = i >> 11;
        float ar, ai, fr, fi; s5_abar(p, l, dr, g, pp, ar, ai, fr, fi);
#pragma unroll
        for (int q = 0; q < 6; ++q) { const float nr = ar * ar - ai * ai, ni = 2.0f * ar * ai; ar = nr; ai = ni; }
        float sr = 0.f, si = 0.f;
        for (int k0 = 0; k0 < 68; k0 += 17) {
            float2 Eb[17];
#pragma unroll
            for (int q = 0; q < 17; ++q) { const int k = k0 + q; const int c = dr == 0 ? k : (k < 4 ? 3 - k : 71 - k); Eb[q] = ST[((size_t)((b * 2 + dr) * 68 + c) * 16 + g) * 64 + pp]; }
#pragma unroll
            for (int q = 0; q < 17; ++q) { const int k = k0 + q; const int c = dr == 0 ? k : (k < 4 ? 3 - k : 71 - k);
                ST[((size_t)((b * 2 + dr) * 68 + c) * 16 + g) * 64 + pp] = make_float2(sr, si);
                const float nr = ar * sr - ai * si + Eb[q].x, ni = ar * si + ai * sr + Eb[q].y; sr = nr; si = ni; }
        }
    }
}

DI float hg_lb(const P& p, int l, int dr, int c) {
    if (l == 0) return 0.f;
    const float e0 = __expf(p.hgrn_lb[(0 * 2 + dr) * 384 + c]), e1 = __expf(p.hgrn_lb[(1 * 2 + dr) * 384 + c]);
    return e1 / (e0 + e1);
}
DI void hg_prep(const P& p, int l, int dr, int h, int row_base, int sb, float* pb) {
    const int tid = tidx(); const int st = tid >> 4, c4 = (tid & 15) * 4;
    const int s = 32 * sb + st; const int tl = dr ? 127 - s : s;
    const bf16_t* z = (const bf16_t*)(p.ws + OFF_ZHG) + (size_t)(row_base + tl) * 1920 + h * 64 + c4;
    const uint2 zq = *(const uint2*)z, zi = *(const uint2*)(z + 384), zf = *(const uint2*)(z + 768 + dr * 384);
    const float qv[4] = {bflo(zq.x), bfhi(zq.x), bflo(zq.y), bfhi(zq.y)}, iv[4] = {bflo(zi.x), bfhi(zi.x), bflo(zi.y), bfhi(zi.y)}, fv[4] = {bflo(zf.x), bfhi(zf.x), bflo(zf.y), bfhi(zf.y)};
    f32x4 fo, ko, vo, qo;
#pragma unroll
    for (int e = 0; e < 4; ++e) {
        const float lb = hg_lb(p, l, dr, h * 64 + c4 + e);
        const float ex = __expf(-fv[e]);
        const float sg = 1.0f / (1.0f + ex);
        const float sgn = 1.0f / (1.0f + __expf(fv[e]));
        fo[e] = lb + (1.0f - lb) * sg; ko[e] = (1.0f - lb) * sgn; vo[e] = iv[e]; qo[e] = qv[e] * sigm(qv[e]);
    }
    float* d = pb + st * 256 + c4;
    *(f32x4*)d = fo; *(f32x4*)(d + 64) = ko; *(f32x4*)(d + 128) = vo; *(f32x4*)(d + 192) = qo;
}
DI void ph_hg1(const P& p, int l, float* lds) {
    float* pb = lds;
    const int tid = tidx(), lane = tid & 63, wv = tid >> 6, jj = lane & 7, ig = lane >> 3;
    float* HGST = (float*)(p.ws + OFF_HGST); float* HGF = (float*)(p.ws + OFF_HGF);
    for (int it = bidx(); it < 1632; it += gridDim.x) {
        const int cidx = it % 34; const int rest = it / 34; const int dr = rest & 1, h = (rest >> 1) % 6, b = rest / 12;
        const int row_base = cidx < 2 ? NLAT + b * 256 + cidx * 128 : b * 4096 + (cidx - 2) * 128;
        float S[8], Fp[8];
#pragma unroll
        for (int e = 0; e < 8; ++e) { S[e] = 0.f; Fp[e] = 1.f; }
        for (int sb = 0; sb < 4; ++sb) {
            __syncthreads();
            hg_prep(p, l, dr, h, row_base, sb, pb);
            __syncthreads();
#pragma unroll 4
            for (int st = 0; st < 32; ++st) {
                const float* q = pb + st * 256;
                const f32x4 f0 = *(const f32x4*)(q + ig * 8), f1 = *(const f32x4*)(q + ig * 8 + 4), k0 = *(const f32x4*)(q + 64 + ig * 8), k1 = *(const f32x4*)(q + 64 + ig * 8 + 4);
                const float vj = q[128 + wv * 8 + jj];
#pragma unroll
                for (int e = 0; e < 4; ++e) { S[e] = f0[e] * S[e] + k0[e] * vj; S[4 + e] = f1[e] * S[4 + e] + k1[e] * vj; Fp[e] *= f0[e]; Fp[4 + e] *= f1[e]; }
            }
        }
        const size_t sbase = (size_t)(((b * 6 + h) * 2 + dr) * 34 + cidx);
#pragma unroll
        for (int e = 0; e < 8; ++e) HGST[sbase * 4096 + (ig * 8 + e) * 64 + wv * 8 + jj] = S[e];
        if (wv == 0 && jj == 0) {
#pragma unroll
            for (int e = 0; e < 8; ++e) HGF[sbase * 64 + ig * 8 + e] = Fp[e];
        }
    }
}
DI void ph_hgcarry(const P& p) {
    float* HGST = (float*)(p.ws + OFF_HGST); const float* HGF = (const float*)(p.ws + OFF_HGF);
    for (int idx = bidx() * 512 + tidx(); idx < 196608; idx += gridDim.x * 512) {
        const int j = idx & 63, i = (idx >> 6) & 63, seq = idx >> 12; const int dr = seq & 1;
        float S = 0.f;
        for (int k0 = 0; k0 < 34; k0 += 17) {
            float Eb[17], Fb[17];
#pragma unroll
            for (int q = 0; q < 17; ++q) { const int k = k0 + q; const int c = dr == 0 ? k : (k < 2 ? 1 - k : 35 - k);
                Eb[q] = HGST[(size_t)(seq * 34 + c) * 4096 + i * 64 + j]; Fb[q] = HGF[(size_t)(seq * 34 + c) * 64 + i]; }
#pragma unroll
            for (int q = 0; q < 17; ++q) { const int k = k0 + q; const int c = dr == 0 ? k : (k < 2 ? 1 - k : 35 - k);
                HGST[(size_t)(seq * 34 + c) * 4096 + i * 64 + j] = S; S = Fb[q] * S + Eb[q]; }
        }
    }
}
DI void ph_hg3(const P& p, int l, float* lds, bool skip_ctx) {
    float* pb = lds; float* osum = lds + 8192;
    const int tid = tidx(), lane = tid & 63, wv = tid >> 6, jj = lane & 7, ig = lane >> 3;
    const float* HGST = (const float*)(p.ws + OFF_HGST);
    bf16_t* Y = (bf16_t*)(p.ws + OFF_R1);
    const bf16_t* ZHG = (const bf16_t*)(p.ws + OFF_ZHG);
    for (int it = bidx(); it < 816; it += gridDim.x) {
        const int cidx = it % 34, h = (it / 34) % 6, b = it / 204;
        if (skip_ctx && cidx < 2) continue;
        const int row_base = cidx < 2 ? NLAT + b * 256 + cidx * 128 : b * 4096 + (cidx - 2) * 128;
        for (int dr = 0; dr < 2; ++dr) {
            const size_t sbase = (size_t)(((b * 6 + h) * 2 + dr) * 34 + cidx);
            float S[8];
#pragma unroll
            for (int e = 0; e < 8; ++e) S[e] = HGST[sbase * 4096 + (ig * 8 + e) * 64 + wv * 8 + jj];
            for (int sb = 0; sb < 4; ++sb) {
                __syncthreads();
                hg_prep(p, l, dr, h, row_base, sb, pb);
                __syncthreads();
                const float* qp = pb + ig * 8;
                f32x4 f0 = *(const f32x4*)(qp), f1 = *(const f32x4*)(qp + 4), k0 = *(const f32x4*)(qp + 64), k1 = *(const f32x4*)(qp + 68), q0 = *(const f32x4*)(qp + 192), q1 = *(const f32x4*)(qp + 196);
                float vj = pb[128 + wv * 8 + jj];
#pragma unroll 4
                for (int st = 0; st < 32; ++st) {
                    const int sn = st < 31 ? st + 1 : 31;
                    const float* qn = pb + sn * 256 + ig * 8;
                    const f32x4 nf0 = *(const f32x4*)(qn), nf1 = *(const f32x4*)(qn + 4), nk0 = *(const f32x4*)(qn + 64), nk1 = *(const f32x4*)(qn + 68), nq0 = *(const f32x4*)(qn + 192), nq1 = *(const f32x4*)(qn + 196);
                    const float nvj = pb[sn * 256 + 128 + wv * 8 + jj];
                    float o = 0.f;
#pragma unroll
                    for (int e = 0; e < 4; ++e) { S[e] = f0[e] * S[e] + k0[e] * vj; S[4 + e] = f1[e] * S[4 + e] + k1[e] * vj; o += q0[e] * S[e] + q1[e] * S[4 + e]; }
                    f0 = nf0; f1 = nf1; k0 = nk0; k1 = nk1; q0 = nq0; q1 = nq1; vj = nvj;
                    o += dppf<0x128>(o);
                    o += __shfl_xor(o, 16);
                    o += __shfl_xor(o, 32);
                    const int s = 32 * sb + st; const int tl = dr ? 127 - s : s;
                    if (lane < 8) { float* op = osum + tl * 64 + wv * 8 + jj; if (dr == 0) *op = o; else *op += o; }
                }
            }
        }
        __syncthreads();
        { const int t = tid >> 2, qd = tid & 3;
          const float* op = osum + t * 64 + qd * 16;
          float ov[16]; float ss = 0.f;
#pragma unroll
          for (int q = 0; q < 4; ++q) { const f32x4 o4 = *(const f32x4*)(op + q * 4);
#pragma unroll
              for (int e = 0; e < 4; ++e) { ov[q * 4 + e] = o4[e]; ss += o4[e] * o4[e]; } }
          ss += dppf<0xB1>(ss); ss += dppf<0x4E>(ss);
          const float rs = rsqrtf(ss * (1.0f / 64.0f) + 1e-6f);
          const int row = row_base + t; const int c0 = h * 64 + qd * 16;
          const bf16_t* gz = ZHG + (size_t)row * 1920 + 1536 + c0;
          const uint4 g0 = *(const uint4*)gz, g1 = *(const uint4*)(gz + 8);
          const unsigned gw[8] = {g0.x, g0.y, g0.z, g0.w, g1.x, g1.y, g1.z, g1.w};
          const float* ng = p.hgrn_norm_g + l * 384 + c0;
          unsigned ow[8];
#pragma unroll
          for (int e = 0; e < 8; ++e) {
              const float ga = bflo(gw[e]), gb = bfhi(gw[e]);
              const float oa = ov[2 * e] * rs * ng[2 * e] * (ga * sigm(ga)), ob = ov[2 * e + 1] * rs * ng[2 * e + 1] * (gb * sigm(gb));
              ow[e] = pack2(oa, ob);
          }
          bf16_t* yo = Y + (size_t)row * 1024 + 256 + c0;
          *(uint4*)yo = make_uint4(ow[0], ow[1], ow[2], ow[3]); *(uint4*)(yo + 8) = make_uint4(ow[4], ow[5], ow[6], ow[7]); }
    }
}


constexpr int HS = 72;
constexpr size_t OFF_HGF2 = OFF_HGST + 26738688;
static_assert(OFF_HGF2 + 835584 <= OFF_RWP + 8 * ARR, "ws5");
DI bf16x8 ldfrag(const bf16_t* p) { return *(const bf16x8*)p; }
DI int hgm_rowbase(int cidx, int b) { return cidx < 4 ? NLAT + b * 256 + cidx * 64 : b * 4096 + (cidx - 4) * 64; }

DI void ph_hg1m(const P& p, int l, float* lds) {
    bf16_t* kT = (bf16_t*)lds;
    bf16_t* vT = kT + 64 * HS;
    float* tot = (float*)(vT + 64 * HS);
    const int tid = tidx(), lane = tid & 63, wv = tid >> 6, fr = lane & 15, fq = lane >> 4;
    const int i = lane, o = wv;
    const bf16_t* ZHG = (const bf16_t*)(p.ws + OFF_ZHG);
    bf16_t* ET = (bf16_t*)(p.ws + OFF_HGST); float* HGF = (float*)(p.ws + OFF_HGF2);
    bf16_t* stg = (bf16_t*)(tot + 512);
    const int ls = tid >> 3, lc8 = (tid & 7) * 8;
    uint4 rF, rV, nF, nV;
    auto fetch1 = [&](int it, uint4& xf, uint4& xv) {
        const int cidx = it % 68; const int rest = it / 68; const int dr = rest & 1, h = (rest >> 1) % 6, b = rest / 12;
        const int tl = dr ? 63 - ls : ls;
        const bf16_t* z = ZHG + (size_t)(hgm_rowbase(cidx, b) + tl) * 1920 + h * 64 + lc8;
        xf = *(const uint4*)(z + 768 + dr * 384); xv = *(const uint4*)(z + 384);
    };
    if (bidx() < 3264) fetch1(bidx(), rF, rV);
    for (int it = bidx(); it < 3264; it += gridDim.x) {
        const int cidx = it % 68; const int rest = it / 68; const int dr = rest & 1, h = (rest >> 1) % 6, b = rest / 12;
        const size_t sbase = (size_t)(((b * 6 + h) * 2 + dr) * 68 + cidx);
        const float lb = hg_lb(p, l, dr, h * 64 + i);
        *(uint4*)(stg + ls * 64 + lc8) = rF; *(uint4*)(stg + 4096 + ls * 64 + lc8) = rV;
        if (it + (int)gridDim.x < 3264) fetch1(it + gridDim.x, nF, nV);
        lds_barrier();
        float kv[8], vv[8], G[8];
        float run = 0.f;
#pragma unroll
        for (int e = 0; e < 8; ++e) {
            const float fz = bf2f(stg[(8 * o + e) * 64 + i]); vv[e] = bf2f(stg[4096 + (8 * o + e) * 64 + i]);
            const float sg = frcp(1.0f + __expf(-fz)), sgn = frcp(1.0f + __expf(fz));
            const float f = lb + (1.0f - lb) * sg;
            kv[e] = (1.0f - lb) * sgn;
            run += __logf(f); G[e] = run;
        }
        tot[o * 64 + i] = run;
        lds_barrier();
        float off = 0.f, glast = 0.f;
#pragma unroll
        for (int q = 0; q < 8; ++q) { const float t = tot[q * 64 + i]; if (q < o) off += t; glast += t; }
        unsigned kw[4], vw[4];
#pragma unroll
        for (int e = 0; e < 4; ++e) {
            const float k0 = kv[2 * e] * __expf(glast - (off + G[2 * e])), k1 = kv[2 * e + 1] * __expf(glast - (off + G[2 * e + 1]));
            kw[e] = pack2(k0, k1); vw[e] = pack2(vv[2 * e], vv[2 * e + 1]);
        }
        *(uint4*)(kT + i * HS + 8 * o) = make_uint4(kw[0], kw[1], kw[2], kw[3]);
        *(uint4*)(vT + i * HS + 8 * o) = make_uint4(vw[0], vw[1], vw[2], vw[3]);
        if (o == 0) HGF[sbase * 64 + i] = __expf(glast);
        lds_barrier();
#pragma unroll
        for (int q2 = 0; q2 < 2; ++q2) {
            const int tile = wv * 2 + q2; const int it_ = tile >> 2, jt = tile & 3;
            f32x4 acc = (f32x4){0.f, 0.f, 0.f, 0.f};
#pragma unroll
            for (int ks = 0; ks < 2; ++ks)
                acc = __builtin_amdgcn_mfma_f32_16x16x32_bf16(ldfrag(kT + (16 * it_ + fr) * HS + 32 * ks + 8 * fq), ldfrag(vT + (16 * jt + fr) * HS + 32 * ks + 8 * fq), acc, 0, 0, 0);
            uint2 w; w.x = pack2(acc[0], acc[1]); w.y = pack2(acc[2], acc[3]);
            *(uint2*)(ET + sbase * 4096 + (16 * jt + fr) * 64 + 16 * it_ + fq * 4) = w;
        }
        rF = nF; rV = nV;
    }
}
DI void ph_hgcarrym(const P& p) {
    bf16_t* ST = (bf16_t*)(p.ws + OFF_HGST); const float* HGF = (const float*)(p.ws + OFF_HGF2);
    for (int idx = ((int)gridDim.x - 1 - bidx()) * 512 + tidx(); idx < 49152; idx += gridDim.x * 512) {
        const int i4 = (idx & 15) * 4, j = (idx >> 4) & 63, seq = idx >> 10; const int dr = seq & 1;
        f32x4 S = (f32x4){0.f, 0.f, 0.f, 0.f};
        for (int k0 = 0; k0 < 68; k0 += 17) {
            uint2 Eb[17]; f32x4 Fb[17];
#pragma unroll
            for (int q = 0; q < 17; ++q) { const int k = k0 + q; const int c = dr == 0 ? k : (k < 4 ? 3 - k : 71 - k);
                Eb[q] = *(const uint2*)(ST + (size_t)(seq * 68 + c) * 4096 + j * 64 + i4); Fb[q] = *(const f32x4*)(HGF + (size_t)(seq * 68 + c) * 64 + i4); }
#pragma unroll
            for (int q = 0; q < 17; ++q) { const int k = k0 + q; const int c = dr == 0 ? k : (k < 4 ? 3 - k : 71 - k);
                uint2 o; o.x = pack2(S[0], S[1]); o.y = pack2(S[2], S[3]);
                *(uint2*)(ST + (size_t)(seq * 68 + c) * 4096 + j * 64 + i4) = o;
                const f32x4 E = (f32x4){bflo(Eb[q].x), bfhi(Eb[q].x), bflo(Eb[q].y), bfhi(Eb[q].y)};
                S = Fb[q] * S + E; }
        }
    }
}
DI void ph_hg3m(const P& p, int l, float* lds, bool skip_ctx) {
    bf16_t* qP = (bf16_t*)lds;
    bf16_t* qI = qP + 64 * HS;
    bf16_t* kD = qI + 64 * HS;
    bf16_t* kR = kD + 64 * HS;
    bf16_t* vT = kR + 96 * HS;
    bf16_t* aS = vT + 64 * HS;
    float* tot = (float*)(aS + 64 * HS);
    float* osum = tot + 512;
    const int tid = tidx(), lane = tid & 63, wv = tid >> 6, fr = lane & 15, fq = lane >> 4;
    const int i = lane, o = wv, I = wv >> 1;
    const bf16_t* ZHG = (const bf16_t*)(p.ws + OFF_ZHG);
    const bf16_t* ST = (const bf16_t*)(p.ws + OFF_HGST);
    bf16_t* Y = (bf16_t*)(p.ws + OFF_R1);
    const int nitems = skip_ctx ? 1536 : 1632;
    auto decode = [&](int idx, int& cidx, int& h, int& b) {
        if (skip_ctx) { cidx = 4 + (idx & 63); h = (idx >> 6) % 6; b = idx / 384; } else { cidx = idx % 68; h = (idx / 68) % 6; b = idx / 408; }
    };
    bf16_t* stg = (bf16_t*)(osum + 4096);
    const int ls = tid >> 3, lc8 = (tid & 7) * 8;
    uint4 rQ, rF, rV, nQ, nF, nV;
    auto fetch3 = [&](int idx, int dr, uint4& xq, uint4& xf, uint4& xv) {
        int cidx, h, b; decode(idx, cidx, h, b);
        const int tl = dr ? 63 - ls : ls;
        const bf16_t* z = ZHG + (size_t)(hgm_rowbase(cidx, b) + tl) * 1920 + h * 64 + lc8;
        xq = *(const uint4*)z; xf = *(const uint4*)(z + 768 + dr * 384); xv = *(const uint4*)(z + 384);
    };
    if (bidx() < nitems) fetch3(bidx(), 0, rQ, rF, rV);
    for (int it = bidx(); it < nitems; it += gridDim.x) {
        int cidx, h, b; decode(it, cidx, h, b);
        const int row_base = hgm_rowbase(cidx, b);
        lds_barrier();
        for (int q = tid; q < 64 * HS / 2; q += 512) ((unsigned*)aS)[q] = 0u;
        for (int dr = 0; dr < 2; ++dr) {
            const size_t sbase = (size_t)(((b * 6 + h) * 2 + dr) * 68 + cidx);
            const float lb = hg_lb(p, l, dr, h * 64 + i);
            *(uint4*)(stg + ls * 64 + lc8) = rQ; *(uint4*)(stg + 4096 + ls * 64 + lc8) = rF; *(uint4*)(stg + 8192 + ls * 64 + lc8) = rV;
            if (dr == 0) fetch3(it, 1, nQ, nF, nV);
            else if (it + (int)gridDim.x < nitems) fetch3(it + gridDim.x, 0, nQ, nF, nV);
            bf16x8 sfr[2][2];
#pragma unroll
            for (int q2 = 0; q2 < 2; ++q2)
#pragma unroll
                for (int ks = 0; ks < 2; ++ks) sfr[q2][ks] = ldfrag(ST + sbase * 4096 + (16 * ((wv & 1) * 2 + q2) + fr) * 64 + 8 * fq + 32 * ks);
            lds_barrier();
            float kv[8], vv[8], qv[8], G[8];
            float run = 0.f;
#pragma unroll
            for (int e = 0; e < 8; ++e) {
                const int so = (8 * o + e) * 64 + i;
                const float qz = bf2f(stg[so]); const float fz = bf2f(stg[4096 + so]); vv[e] = bf2f(stg[8192 + so]);
                const float sg = frcp(1.0f + __expf(-fz)), sgn = frcp(1.0f + __expf(fz));
                const float f = lb + (1.0f - lb) * sg;
                kv[e] = (1.0f - lb) * sgn; qv[e] = qz * sigm(qz);
                run += __logf(f); G[e] = run;
            }
            tot[o * 64 + i] = run;
            lds_barrier();
            float gb[5]; gb[0] = 0.f;
            float off = 0.f;
#pragma unroll
            for (int q = 0; q < 8; ++q) { const float t = tot[q * 64 + i]; if (q < o) off += t; if (q & 1) gb[(q >> 1) + 1] = 0.f; }
            { float acc2 = 0.f;
#pragma unroll
              for (int q = 0; q < 8; ++q) { acc2 += tot[q * 64 + i]; if (q & 1) gb[(q >> 1) + 1] = acc2; } }
            const float gbI = I == 0 ? gb[0] : I == 1 ? gb[1] : I == 2 ? gb[2] : gb[3];
            const float egb = __expf(gbI);
            unsigned vw[4];
#pragma unroll
            for (int e = 0; e < 8; ++e) {
                const int s = 8 * o + e;
                const float Gs = off + G[e];
                const float ef = __expf(Gs - gbI);
                qI[s * HS + i] = f2bf(qv[e] * ef);
                qP[s * HS + i] = f2bf(qv[e] * ef * egb);
                kD[s * HS + i] = f2bf(kv[e] * frcp(fmaxf(ef, 1e-35f)));
                if (I < 1) kR[(0 + s) * HS + i] = f2bf(kv[e] * __expf(gb[1] - Gs));
                if (I < 2) kR[(16 + s) * HS + i] = f2bf(kv[e] * __expf(gb[2] - Gs));
                if (I < 3) kR[(48 + s) * HS + i] = f2bf(kv[e] * __expf(gb[3] - Gs));
            }
#pragma unroll
            for (int e = 0; e < 4; ++e) vw[e] = pack2(vv[2 * e], vv[2 * e + 1]);
            *(uint4*)(vT + i * HS + 8 * o) = make_uint4(vw[0], vw[1], vw[2], vw[3]);
            lds_barrier();
            for (int tt = wv; tt < 10; tt += 8) {
                const int TI = tt < 1 ? 0 : tt < 3 ? 1 : tt < 6 ? 2 : 3; const int TJ = tt - (TI * (TI + 1)) / 2;
                const int kbase = TI == 1 ? 0 : TI == 2 ? 16 : 48;
                const bf16_t* ap = qI + (16 * TI + fr) * HS + 8 * fq;
                const bf16_t* bp = (TJ == TI) ? kD + (16 * TI + fr) * HS + 8 * fq : kR + (kbase + 16 * TJ + fr) * HS + 8 * fq;
                f32x4 acc = (f32x4){0.f, 0.f, 0.f, 0.f};
#pragma unroll
                for (int ks = 0; ks < 2; ++ks) acc = __builtin_amdgcn_mfma_f32_16x16x32_bf16(ldfrag(ap + 32 * ks), ldfrag(bp + 32 * ks), acc, 0, 0, 0);
#pragma unroll
                for (int r = 0; r < 4; ++r) { const int sl = fq * 4 + r; const float val = (TJ == TI && fr > sl) ? 0.f : acc[r]; aS[(16 * TI + sl) * HS + 16 * TJ + fr] = f2bf(val); }
            }
            lds_barrier();
#pragma unroll
            for (int q2 = 0; q2 < 2; ++q2) {
                const int jt = (wv & 1) * 2 + q2;
                f32x4 acc = (f32x4){0.f, 0.f, 0.f, 0.f};
                const bf16_t* a1 = qP + (16 * I + fr) * HS + 8 * fq;
                const bf16_t* a2 = aS + (16 * I + fr) * HS + 8 * fq; const bf16_t* b2 = vT + (16 * jt + fr) * HS + 8 * fq;
#pragma unroll
                for (int ks = 0; ks < 2; ++ks) acc = __builtin_amdgcn_mfma_f32_16x16x32_bf16(ldfrag(a1 + 32 * ks), sfr[q2][ks], acc, 0, 0, 0);
#pragma unroll
                for (int ks = 0; ks < 2; ++ks) acc = __builtin_amdgcn_mfma_f32_16x16x32_bf16(ldfrag(a2 + 32 * ks), ldfrag(b2 + 32 * ks), acc, 0, 0, 0);
#pragma unroll
                for (int r = 0; r < 4; ++r) { const int s = 16 * I + fq * 4 + r; const int tl = dr ? 63 - s : s; float* op = osum + tl * 64 + 16 * jt + fr; if (dr == 0) *op = acc[r]; else *op += acc[r]; }
            }
            rQ = nQ; rF = nF; rV = nV;
        }
        lds_barrier();
        { const int t = tid >> 3, oc = tid & 7;
          const float* op = osum + t * 64 + oc * 8;
          const f32x4 o0 = *(const f32x4*)op, o1 = *(const f32x4*)(op + 4);
          float ss = o0[0] * o0[0] + o0[1] * o0[1] + o0[2] * o0[2] + o0[3] * o0[3] + o1[0] * o1[0] + o1[1] * o1[1] + o1[2] * o1[2] + o1[3] * o1[3];
          ss += dppf<0xB1>(ss); ss += dppf<0x4E>(ss); ss += dppf<0x141>(ss);
          const float rs = rsqrtf(ss * (1.0f / 64.0f) + 1e-6f);
          const int row = row_base + t; const int c0 = h * 64 + oc * 8;
          const uint4 g0 = *(const uint4*)(ZHG + (size_t)row * 1920 + 1536 + c0);
          const unsigned gw[4] = {g0.x, g0.y, g0.z, g0.w};
          const float* ng = p.hgrn_norm_g + l * 384 + c0;
          const float ov[8] = {o0[0], o0[1], o0[2], o0[3], o1[0], o1[1], o1[2], o1[3]};
          unsigned ow[4];
#pragma unroll
          for (int e = 0; e < 4; ++e) {
              const float ga = bflo(gw[e]), gbv = bfhi(gw[e]);
              ow[e] = pack2(ov[2 * e] * rs * ng[2 * e] * (ga * sigm(ga)), ov[2 * e + 1] * rs * ng[2 * e + 1] * (gbv * sigm(gbv)));
          }
          *(uint4*)(Y + (size_t)row * 1024 + 256 + c0) = make_uint4(ow[0], ow[1], ow[2], ow[3]); }
    }
}

DI void ph_rwread(const P& p, int l, int nrows) {
    const int tid = tidx(), lane = tid & 63, sub = lane >> 4, l16 = lane & 15;
    const bf16_t* GATE = (const bf16_t*)(p.ws + OFF_GATE); const bf16_t* Vv = (const bf16_t*)(p.ws + OFF_V);
    const bf16_t* YF = (const bf16_t*)(p.ws + OFF_R2); const bf16_t* YB = (const bf16_t*)(p.ws + OFF_R2 + ARR);
    const float* CB = (const float*)(p.ws + OFF_CB);
    bf16_t* Y = (bf16_t*)(p.ws + OFF_R1);
    const int ngrp = nrows * 6 / 4, nw = gridDim.x * 8;
    for (int grp0 = bidx() * 8 + (tid >> 6); grp0 < ngrp; grp0 += 2 * nw) {
        uint2 yf[2], yb[2], vx[2], gx[2]; float cb[2]; int srs[2], cs[2]; bool ok[2];
#pragma unroll
        for (int u = 0; u < 2; ++u) {
            const int grp = grp0 + u * nw; ok[u] = grp < ngrp;
            const int task = (ok[u] ? grp : grp0) * 4 + sub; const int sr = task / 6, h = task % 6, c = h * 64 + l16 * 4;
            srs[u] = sr; cs[u] = c;
            const size_t o = (size_t)sr * 384 + c;
            yf[u] = *(const uint2*)(YF + o); yb[u] = *(const uint2*)(YB + o); vx[u] = *(const uint2*)(Vv + o); gx[u] = *(const uint2*)(GATE + o);
            cb[u] = CB[(size_t)sr * 6 + h];
        }
#pragma unroll
        for (int u = 0; u < 2; ++u) {
            const int sr = srs[u], c = cs[u];
            const f32x4 lw = *(const f32x4*)(p.rwkv_ln_w + l * 384 + c), lb4 = *(const f32x4*)(p.rwkv_ln_b + l * 384 + c);
            const float y4[4] = {bflo(yf[u].x) + bflo(yb[u].x), bfhi(yf[u].x) + bfhi(yb[u].x), bflo(yf[u].y) + bflo(yb[u].y), bfhi(yf[u].y) + bfhi(yb[u].y)};
            const float v4[4] = {bflo(vx[u].x), bfhi(vx[u].x), bflo(vx[u].y), bfhi(vx[u].y)}, g4[4] = {bflo(gx[u].x), bfhi(gx[u].x), bflo(gx[u].y), bfhi(gx[u].y)};
            const float mean = red16((y4[0] + y4[1]) + (y4[2] + y4[3])) * (1.0f / 64.0f);
            float d4[4], vs = 0.f;
#pragma unroll
            for (int e = 0; e < 4; ++e) { d4[e] = y4[e] - mean; vs += d4[e] * d4[e]; }
            const float rstd = rsqrtf(red16(vs) * (1.0f / 64.0f) + 64e-5f);
            float o4[4];
#pragma unroll
            for (int e = 0; e < 4; ++e) o4[e] = (d4[e] * rstd * lw[e] + lb4[e] + cb[u] * v4[e]) * g4[e];
            uint2 t; t.x = pack2(o4[0], o4[1]); t.y = pack2(o4[2], o4[3]);
            if (ok[u]) *(uint2*)(Y + (size_t)permrow(sr) * 1024 + 640 + c) = t;
        }
    }
}

DI void ph_final(const P& p) {
    const int tid = tidx(), lane = tid & 63;
    for (int m = bidx() * 8 + (tid >> 6); m < NLAT; m += gridDim.x * 8) {
        float* src = p.out + (size_t)m * 1024;
        f32x4 v[4]; float ss = 0.f;
#pragma unroll
        for (int j = 0; j < 4; ++j) { v[j] = *(const f32x4*)(src + j * 256 + lane * 4); ss += v[j][0] * v[j][0] + v[j][1] * v[j][1] + v[j][2] * v[j][2] + v[j][3] * v[j][3]; }
        ss = wave_sum(ss);
        const float rstd = rsqrtf(ss * (1.0f / 1024.0f) + 1e-6f);
#pragma unroll
        for (int j = 0; j < 4; ++j) { const int col = j * 256 + lane * 4; const f32x4 g4 = *(const f32x4*)(p.norm_f_g + col); *(f32x4*)(src + col) = v[j] * rstd * g4; }
    }
}


#define XB_TMO      128
#define XB_XCNT(j)  (256  + 64 * (j))
#define XB_XSUB(j)  (1280 + 64 * (j))
#define XB_XGEN(j)  (2304 + 64 * (j))
#define XB_TOP      3328
#define XB_TOPGEN   3392
#define XCD_BAR_WORDS 3456
#define XB_SPIN_CAP (1u << 18)
#define LAS __attribute__((address_space(3)))
DI unsigned xb_ld(unsigned* p)              { return __hip_atomic_load(p, __ATOMIC_RELAXED, __HIP_MEMORY_SCOPE_AGENT); }
DI unsigned xb_add(unsigned* p, unsigned v) { return __hip_atomic_fetch_add(p, v, __ATOMIC_RELAXED, __HIP_MEMORY_SCOPE_AGENT); }
DI unsigned xb_xcc_id() { return (unsigned)__builtin_amdgcn_s_getreg((3 << 11) | 20) & 0xFu; }
#define XB_SPIN(cond, bar) do { unsigned _sp = 0; while (cond) { __builtin_amdgcn_s_sleep(1); \
    if ((++_sp & 255u) == 0u) { if (xb_ld(&(bar)[XB_TMO])) break; if (_sp > XB_SPIN_CAP) { atomicAdd(&(bar)[XB_TMO], 1u); break; } } } } while (0)
struct XcdBarrier { unsigned* bar; unsigned x; volatile LAS unsigned* st; };
DI XcdBarrier xcd_barrier_post(unsigned* bar, volatile LAS unsigned* st) {
    XcdBarrier b; b.bar = bar; b.x = xb_xcc_id(); b.st = st;
    if (threadIdx.x == 0) (void)xb_add(&bar[XB_XCNT(b.x)], 1u);
    return b;
}
DI void xcd_barrier_complete(unsigned* bar, unsigned x, unsigned& nloc, unsigned& nx) {
    const unsigned G = gridDim.x * gridDim.y * gridDim.z;
    unsigned sum, cnt, mine, sp = 0u;
    for (;;) {
        sum = 0u; cnt = 0u; mine = 0u;
#pragma unroll
        for (unsigned j = 0; j < 16; ++j) { const unsigned c = xb_ld(&bar[XB_XCNT(j)]); sum += c; cnt += (c > 0u) ? 1u : 0u; mine = (j == x) ? c : mine; }
        if (sum == G) break;
        __builtin_amdgcn_s_sleep(1);
        if ((++sp & 255u) == 0u) { if (xb_ld(&bar[XB_TMO])) break; if (sp > XB_SPIN_CAP) { atomicAdd(&bar[XB_TMO], 1u); break; } }
    }
    nloc = mine > 0u ? mine : 1u; nx = cnt > 0u ? cnt : 1u;
}
DI void xcd_barrier(const XcdBarrier& b) {
    asm volatile("s_waitcnt vmcnt(0)" ::: "memory");
    __syncthreads();
    if (threadIdx.x == 0) {
        unsigned* bar = b.bar;
        __builtin_amdgcn_s_waitcnt(0);
        unsigned nloc = b.st[0], nx = b.st[1];
        if (nloc == 0u) { xcd_barrier_complete(bar, b.x, nloc, nx); b.st[0] = nloc; b.st[1] = nx; }
        const unsigned old = xb_add(&bar[XB_XSUB(b.x)], 1u);
        const unsigned gen = old / nloc;
        if (old + 1u == (gen + 1u) * nloc) {
            __builtin_amdgcn_fence(__ATOMIC_RELEASE, "agent");
            asm volatile("s_waitcnt vmcnt(0)" ::: "memory");
            const unsigned og = xb_add(&bar[XB_TOP], 1u);
            const unsigned tg = og / nx;
            if (og + 1u == (tg + 1u) * nx) xb_add(&bar[XB_TOPGEN], 1u);
            else XB_SPIN(xb_ld(&bar[XB_TOPGEN]) == tg, bar);
            __builtin_amdgcn_fence(__ATOMIC_ACQUIRE, "agent");
            xb_add(&bar[XB_XGEN(b.x)], 1u);
            asm volatile("s_waitcnt vmcnt(0)" ::: "memory");
        } else {
            XB_SPIN(xb_ld(&bar[XB_XGEN(b.x)]) == gen, bar);
            __builtin_amdgcn_fence(__ATOMIC_ACQUIRE, "agent");
            asm volatile("s_waitcnt vmcnt(0)" ::: "memory");
        }
    }
    __syncthreads();
}

DI void sub_barrier(unsigned* ctr, unsigned target) {
    asm volatile("s_waitcnt vmcnt(0)" ::: "memory");
    __syncthreads();
    if (threadIdx.x == 0) {
        __builtin_amdgcn_fence(__ATOMIC_RELEASE, "agent");
        asm volatile("s_waitcnt vmcnt(0)" ::: "memory");
        (void)xb_add(ctr, 1u);
        unsigned sp = 0;
        while (xb_ld(ctr) < target) { __builtin_amdgcn_s_sleep(2); if (++sp > (1u << 22)) break; }
        __builtin_amdgcn_fence(__ATOMIC_ACQUIRE, "agent");
        asm volatile("s_waitcnt vmcnt(0)" ::: "memory");
    }
    __syncthreads();
}


#if defined(__HIP_DEVICE_COMPILE__)
DI P ldp() { unsigned long long k = (unsigned long long)__builtin_amdgcn_kernarg_segment_ptr(); asm volatile("" : "+s"(k)); return *(const __attribute__((address_space(4))) P*)k; }
#else
__device__ P ldp();
#endif
template <int MODE> DI void run_gemm(PG8_LAS unsigned char* lds, const bf16_t* A, const bf16_t* Bt, int M, int N, int K, const Epi<MODE>& E, int gsz = -1, int gidx = -1) {
    asm volatile("" : "+s"(M), "+s"(N), "+s"(K));
    pg8::StaticOrder S; S.init(M, N, gsz < 0 ? (int)gridDim.x : gsz, gidx < 0 ? (int)bidx() : gidx);
    pg8::Gemm g; g.A = A; g.Bt = Bt; g.M = M; g.N = N; g.K = K; g.lda = K; g.ldb = K; g.tps = 1 << 20;
    pg8::gemm_phase(lds, g, S, E);
}

template <int MODE> DI void run_gemm_split(PG8_LAS unsigned char* lds, const bf16_t* A, const bf16_t* Bt, int rows_real, int N, int K, int nslice, int ld, const Epi<MODE>& E) {
    int M = rows_real * nslice;
    asm volatile("" : "+s"(M), "+s"(N), "+s"(K), "+s"(ld));
    pg8::StaticOrder S; S.init(M, N, (int)gridDim.x, (int)bidx());
    pg8::Gemm g; g.A = A; g.Bt = Bt; g.M = M; g.N = N; g.K = K; g.lda = ld; g.ldb = ld; g.tps = rows_real / 256;
    pg8::gemm_phase(lds, g, S, E);
}

__global__ void __launch_bounds__(512, 2) mega(P p_unused) {
    extern __shared__ __attribute__((aligned(16))) unsigned char shm[];
    cg::grid_group grid = cg::this_grid();
    __shared__ uint4 xb_words;
    if (threadIdx.x == 0) xb_words = make_uint4(0u, 0u, 0u, 0u);
    __syncthreads();
    const XcdBarrier xb = xcd_barrier_post((unsigned*)(ldp().ws + OFF_BAR), (volatile LAS unsigned*)&xb_words);
    float* lds = (float*)shm;
    PG8_LAS unsigned char* lds3 = (PG8_LAS unsigned char*)shm;
#define H ((const bf16_t*)(ldp().ws + OFF_R1))
#define WT ((const bf16_t*)(ldp().ws + OFF_R3))
#define WT_OUT (WT + 3840 * 1024)
#define WT_FF1 (WT + 3840 * 1024 + 1024 * 1024)
#define WT_FF2 (WT + 3840 * 1024 + 1024 * 1024 + 4096 * 1024)
#define xc ((float*)(ldp().ws + OFF_XC))
#define mod ((const float*)(ldp().ws + OFF_MOD))

    REP(512) { ph_mods(ldp(), lds);
    ph_convert(ldp(), 0, lds, 0); }
    grid.sync();
    for (int l = 0; l < 2; ++l) {
        const int mrows = l == 0 ? NTOK : NLAT;
        if (l == 1) ph_convert(ldp(), 1, lds, 0);
        ph_norm(ldp(), l, 0, NTOK);
        xcd_barrier(xb);
        { Epi<7> E{}; E.o0 = (bf16_t*)(ldp().ws + OFF_R2); E.o1 = (bf16_t*)(ldp().ws + OFF_ZS5); E.o2 = (bf16_t*)(ldp().ws + OFF_ZHG); run_gemm<7>(lds3, H, WT, NTOK, 3840, 1024, E); }
        xcd_barrier(xb);
        ph_hg1m(ldp(), l, lds);
        xcd_barrier(xb);
        ph_hgcarrym(ldp());
        ph_s5<false>(ldp(), l, lds, bidx(), gridDim.x);
        xcd_barrier(xb);
        ph_hg3m(ldp(), l, lds, l == 1);
        if (gridDim.x >= 32) { if (bidx() >= (int)gridDim.x - 16) ph_s5carry(ldp(), l, bidx() - ((int)gridDim.x - 16), 16); }
        else ph_s5carry(ldp(), l, bidx(), gridDim.x);
        xcd_barrier(xb);
        ph_rwp1(ldp(), l, lds);
        xcd_barrier(xb);
        { Epi<4> E{}; E.o0 = (bf16_t*)(ldp().ws + OFF_R2); E.o1 = (bf16_t*)(ldp().ws + OFF_GATE); run_gemm<4>(lds3, (const bf16_t*)(ldp().ws + OFF_AUXA), (const bf16_t*)(ldp().ws + OFF_WAUX), NTOK, 2048, 384, E); }
        xcd_barrier(xb);
        ph_rwp2(ldp(), l);
        xcd_barrier(xb);
        ph_rwscan(ldp(), lds);
        const bool s5_in_c = gridDim.x > 192;
        if (s5_in_c) {
            if (bidx() >= 192) {
                const int hb = bidx() - 192, nh = gridDim.x - 192;
                unsigned* ctr = (unsigned*)(ldp().ws + OFF_BAR);
                ph_s5<true>(ldp(), l, lds, hb, nh);
                sub_barrier(ctr, (unsigned)((l + 1) * nh));
                { Epi<5> E{}; E.o0 = (bf16_t*)(ldp().ws + OFF_R1); E.o1 = (bf16_t*)(ldp().ws + OFF_G5); E.gate = ldp().s5_b_glu + l * 256; run_gemm<5>(lds3, (const bf16_t*)(ldp().ws + OFF_G5), (const bf16_t*)(ldp().ws + OFF_WGLU), mrows, 256, 256, E, nh, hb); }
            }
        } else ph_s5<true>(ldp(), l, lds, bidx(), gridDim.x);
        xcd_barrier(xb);
        ph_rwread(ldp(), l, l == 0 ? NTOK : NLAT);
        if (!s5_in_c) { Epi<5> E{}; E.o0 = (bf16_t*)(ldp().ws + OFF_R1); E.o1 = (bf16_t*)(ldp().ws + OFF_G5); E.gate = ldp().s5_b_glu + l * 256; run_gemm<5>(lds3, (const bf16_t*)(ldp().ws + OFF_G5), (const bf16_t*)(ldp().ws + OFF_WGLU), mrows, 256, 256, E); }
        xcd_barrier(xb);
        ph_convert(ldp(), l, lds, 1);
        if (l == 0) { Epi<6> E{}; E.xout_lat = (float*)(ldp().ws + OFF_R2);
          run_gemm_split<6>(lds3, H + (size_t)NLAT * 1024, WT_OUT, 1024, 1024, 256, 4, 1024, E); }
        { Epi<2> E{}; E.xin_lat = l == 0 ? ldp().x : ldp().out; E.xout_lat = ldp().out; E.xin_ctx = l == 0 ? ldp().ctx : xc; E.xout_ctx = xc; E.gate = mod + (size_t)l * 5 * 6144 + 2 * 1024;
          run_gemm<2>(lds3, H, WT_OUT, NLAT, 1024, 1024, E); }
        xcd_barrier(xb);
        REP(64) ph_norm(ldp(), l, 1, mrows);
        xcd_barrier(xb);
        REP(2048) if (PHM & 2048) { Epi<3> E{}; E.o0 = (bf16_t*)(ldp().ws + OFF_HID); run_gemm<3>(lds3, H, WT_FF1, mrows, 4096, 1024, E); }
        xcd_barrier(xb);
        if (l == 0) { Epi<6> E{}; E.xout_lat = (float*)(ldp().ws + OFF_R2);
          run_gemm_split<6>(lds3, (const bf16_t*)(ldp().ws + OFF_HID) + (size_t)NLAT * 4096, WT_FF2, 1024, 1024, 512, 8, 4096, E); }
        { Epi<2> E{}; E.xin_lat = ldp().out; E.xout_lat = ldp().out; E.xin_ctx = xc; E.xout_ctx = xc; E.gate = mod + (size_t)l * 5 * 6144 + 5 * 1024;
          run_gemm<2>(lds3, (const bf16_t*)(ldp().ws + OFF_HID), WT_FF2, NLAT, 1024, 4096, E); }
        xcd_barrier(xb);
    }
    ph_final(ldp());
#undef H
#undef WT
#undef WT_OUT
#undef WT_FF1
#undef WT_FF2
#undef xc
#undef mod
}

extern "C" void kernel_launch(void* const* d_in, const int* in_sizes, int n_in, void* d_out, int out_size, void* d_ws, size_t ws_size, hipStream_t stream) {
    P p{};
    const float** f = (const float**)&p;
    for (int i = 0; i < 36; ++i) f[i] = (const float*)d_in[i];
    p.out = (float*)d_out; p.ws = (unsigned char*)d_ws;
    static int grid_blocks = 0;
    if (!grid_blocks) {
        int dev = 0, cus = 0, per_cu = 0;
        hipGetDevice(&dev);
        hipDeviceGetAttribute(&cus, hipDeviceAttributeMultiprocessorCount, dev);
        hipFuncSetAttribute((const void*)mega, hipFuncAttributeMaxDynamicSharedMemorySize, LDS_BYTES);
        hipOccupancyMaxActiveBlocksPerMultiprocessor(&per_cu, mega, 512, LDS_BYTES);
        if (per_cu < 1) per_cu = 1;
        grid_blocks = cus * per_cu;
        if (grid_blocks > 256) grid_blocks = 256;
    }
    if (ws_size < OFF_BAR + 3456 * 4) fprintf(stderr, "workspace too small: %zu < %zu\n", ws_size, (size_t)WS_NEEDED);
    hipMemsetAsync((unsigned char*)d_ws + OFF_BAR, 0, 3456 * 4, stream);
    void* args[] = {&p};
    hipError_t e = hipLaunchCooperativeKernel((void*)mega, dim3(grid_blocks), dim3(512), args, LDS_BYTES, stream);
    if (e != hipSuccess) fprintf(stderr, "cooperative launch failed: %s (grid %d)\n", hipGetErrorString(e), grid_blocks);
}
```
